# Optimizing an MI355X kernel written in HIP

```python
import jax, jax.numpy as jnp
from jax import lax
import numpy as np

D_MODEL = 1024
BATCH = 16
SEQ = 4096
DEPTH = 1
DEC_BATCH = 2
DEC_SEQ = 8192
PAST_LEN = 128

HEAD_DIM = 64
A_Q_HEADS = 8
A_KV_HEADS = 2
A_GROUP = A_Q_HEADS // A_KV_HEADS
B_WIN_DIL = ((128, 1), (512, 4), (2048, 16))
B_N_GROUPS = 3
B_HEADS_PER_GROUP = 4
B_HEADS = B_N_GROUPS * B_HEADS_PER_GROUP
D_FF = 2816
GRID_W = 64
Q_BLOCK = 128
ROPE_THETA = 500000.0
AXIAL_THETA = 10000.0
ROT_DIMS = HEAD_DIM // 4
EPS = 1e-6
NEG_INF = -1e30
A_Q_W = A_Q_HEADS * HEAD_DIM
A_KV_W = A_KV_HEADS * HEAD_DIM
B_W = B_HEADS * HEAD_DIM
B_OUT_W = B_HEADS_PER_GROUP * HEAD_DIM
IN_W = A_Q_W + 2 * A_KV_W + 3 * B_W + 2 * D_MODEL

kernel_name = "hybrid_gated_gqa_dilated_encoder"


def rms_norm(x, g):
    xf = x.astype(jnp.float32)
    y = xf * lax.rsqrt(jnp.mean(xf * xf, axis=-1, keepdims=True) + EPS)
    return (y * g.astype(jnp.float32)).astype(x.dtype)


def rope(x, pos, theta):
    r = x.shape[-1]
    inv = theta ** (-jnp.arange(0, r, 2, dtype=jnp.float32) / r)
    ang = pos[:, None] * inv[None, :]
    cos = jnp.cos(ang)[None, :, None, :]
    sin = jnp.sin(ang)[None, :, None, :]
    xf = x.astype(jnp.float32)
    x1, x2 = xf[..., : r // 2], xf[..., r // 2:]
    out = jnp.concatenate([x1 * cos - x2 * sin, x2 * cos + x1 * sin], axis=-1)
    return out.astype(x.dtype)


def partial_rope(x, pos):
    return jnp.concatenate([rope(x[..., :ROT_DIMS], pos, ROPE_THETA), x[..., ROT_DIMS:]], axis=-1)


def axial_rope(x, row, col):
    half = HEAD_DIM // 2
    return jnp.concatenate([rope(x[..., :half], row, AXIAL_THETA),
                            rope(x[..., half:], col, AXIAL_THETA)], axis=-1)


def swiglu(x, w13, w2):
    a, b = jnp.split(x @ w13, 2, axis=-1)
    return (jax.nn.silu(a) * b) @ w2


def grid_gqa(q, k, v):
    bsz, s_len = q.shape[:2]
    nb = s_len // Q_BLOCK
    scale = HEAD_DIM ** -0.5
    qg = q.reshape(bsz, s_len, A_KV_HEADS, A_GROUP, HEAD_DIM)

    def blk(i):
        qb = lax.dynamic_slice_in_dim(qg, i * Q_BLOCK, Q_BLOCK, axis=1)
        s = jnp.einsum('bqkgd,bskd->bkgqs', qb, k).astype(jnp.float32) * scale
        p = jax.nn.softmax(s, axis=-1).astype(v.dtype)
        return jnp.einsum('bkgqs,bskd->bqkgd', p, v)

    o = lax.map(blk, jnp.arange(nb))
    return jnp.moveaxis(o, 0, 1).reshape(bsz, s_len, A_Q_W)


def dilated_mix(q, k, v):
    bsz, s_len = q.shape[:2]
    nb = s_len // Q_BLOCK
    scale = HEAD_DIM ** -0.5
    shp = (bsz, s_len, B_N_GROUPS, B_HEADS_PER_GROUP, HEAD_DIM)
    qg, kg_all, vg_all = q.reshape(shp), k.reshape(shp), v.reshape(shp)

    def blk(i):
        pos = i * Q_BLOCK + jnp.arange(Q_BLOCK)
        qb = lax.dynamic_slice_in_dim(qg, i * Q_BLOCK, Q_BLOCK, axis=1)
        outs, lses = [], []
        for g, (win, dil) in enumerate(B_WIN_DIL):
            n_side = win // (2 * dil)
            offs = dil * jnp.arange(-n_side, n_side + 1)
            idx = pos[:, None] + offs[None, :]
            valid = (idx >= 0) & (idx < s_len)
            idx = jnp.clip(idx, 0, s_len - 1)
            kg = jnp.take(kg_all[:, :, g], idx, axis=1)
            vg = jnp.take(vg_all[:, :, g], idx, axis=1)
            s = jnp.einsum('bqhd,bqjhd->bqhj', qb[:, :, g], kg).astype(jnp.float32) * scale
            s = jnp.where(valid[None, :, None, :], s, NEG_INF)
            lse = jax.nn.logsumexp(s, axis=-1, keepdims=True)
            p = jnp.exp(s - lse).astype(v.dtype)
            outs.append(jnp.einsum('bqhj,bqjhd->bqhd', p, vg))
            lses.append(lse[..., 0])
        wts = jax.nn.softmax(jnp.stack(lses, axis=0), axis=0).astype(v.dtype)
        return jnp.einsum('gbqh,gbqhd->bqhd', wts, jnp.stack(outs, axis=0))

    o = lax.map(blk, jnp.arange(nb))
    return jnp.moveaxis(o, 0, 1).reshape(bsz, s_len, B_OUT_W)


def encoder_layer(x, n1, w13_1, w2_1, nm, w_in, qn, kn, w_ba, w_bb, w_o, n2, w13_2, w2_2):
    bsz, s_len, _ = x.shape
    x = x + 0.5 * swiglu(rms_norm(x, n1), w13_1, w2_1)
    h = rms_norm(x, nm)
    proj = h @ w_in
    cuts = np.cumsum([A_Q_W, A_KV_W, A_KV_W, B_W, B_W, B_W, D_MODEL])
    qa, ka, va, qb, kb, vb, ga, gb = jnp.split(proj, cuts, axis=-1)
    rows = s_len // GRID_W
    t = jnp.arange(s_len, dtype=jnp.float32)
    row = jnp.repeat(jnp.arange(rows, dtype=jnp.float32), GRID_W)
    col = jnp.tile(jnp.arange(GRID_W, dtype=jnp.float32), rows)
    qa = axial_rope(rms_norm(qa.reshape(bsz, s_len, A_Q_HEADS, HEAD_DIM), qn), row, col)
    ka = axial_rope(rms_norm(ka.reshape(bsz, s_len, A_KV_HEADS, HEAD_DIM), kn), row, col)
    va = va.reshape(bsz, s_len, A_KV_HEADS, HEAD_DIM)
    out_a = grid_gqa(qa, ka, va) @ w_ba
    qb = partial_rope(qb.reshape(bsz, s_len, B_HEADS, HEAD_DIM), t)
    kb = partial_rope(kb.reshape(bsz, s_len, B_HEADS, HEAD_DIM), t)
    vb = vb.reshape(bsz, s_len, B_HEADS, HEAD_DIM)
    out_b = dilated_mix(qb, kb, vb) @ w_bb
    merged = jax.nn.sigmoid(ga) * out_a + jax.nn.sigmoid(gb) * out_b
    x = x + merged @ w_o
    x = x + 0.5 * swiglu(rms_norm(x, n2), w13_2, w2_2)
    return x


def setup_inputs(seed: int = 0) -> dict:
    key = jax.random.key(seed)
    ks = jax.random.split(key, 20)

    def w(k, shape, fan_in):
        return jax.random.normal(k, shape, jnp.float32) * fan_in ** -0.5

    def gain(k, shape):
        return 1.0 + 0.02 * jax.random.normal(k, shape, jnp.float32)

    L = DEPTH
    return {
        "x_prompt": jax.random.normal(ks[0], (BATCH, SEQ, D_MODEL), jnp.float32),
        "x_sample": jax.random.normal(ks[1], (DEC_BATCH, DEC_SEQ, D_MODEL), jnp.float32),
        "norm_ffn1": gain(ks[2], (L, D_MODEL)),
        "w13_ffn1": w(ks[3], (L, D_MODEL, 2 * D_FF), D_MODEL),
        "w2_ffn1": w(ks[4], (L, D_FF, D_MODEL), D_FF),
        "norm_mix": gain(ks[5], (L, D_MODEL)),
        "w_in": w(ks[6], (L, D_MODEL, IN_W), D_MODEL),
        "q_norm_a": gain(ks[7], (L, HEAD_DIM)),
        "k_norm_a": gain(ks[8], (L, HEAD_DIM)),
        "w_branch_a": w(ks[9], (L, A_Q_W, D_MODEL), A_Q_W),
        "w_branch_b": w(ks[10], (L, B_OUT_W, D_MODEL), B_OUT_W),
        "w_out": w(ks[11], (L, D_MODEL, D_MODEL), D_MODEL),
        "norm_ffn2": gain(ks[12], (L, D_MODEL)),
        "w13_ffn2": w(ks[13], (L, D_MODEL, 2 * D_FF), D_MODEL),
        "w2_ffn2": w(ks[14], (L, D_FF, D_MODEL), D_FF),
        "norm_final": gain(ks[15], (D_MODEL,)),
    }


def reference(x_prompt, x_sample, norm_ffn1, w13_ffn1, w2_ffn1, norm_mix, w_in, q_norm_a,
              k_norm_a, w_branch_a, w_branch_b, w_out, norm_ffn2, w13_ffn2, w2_ffn2, norm_final):
    def trunk(x):
        for l in range(DEPTH):
            x = encoder_layer(x, norm_ffn1[l], w13_ffn1[l], w2_ffn1[l], norm_mix[l], w_in[l],
                              q_norm_a[l], k_norm_a[l], w_branch_a[l], w_branch_b[l], w_out[l],
                              norm_ffn2[l], w13_ffn2[l], w2_ffn2[l])
        return rms_norm(x, norm_final)

    y_prompt = trunk(x_prompt)
    y_sample = trunk(x_sample)
    return (y_prompt, y_sample)
```

```cpp
#include <hip/hip_runtime.h>
#include <hip/hip_cooperative_groups.h>
#include <cstdio>
#include <cstdint>
namespace cg = cooperative_groups;
constexpr int T_ROWS = 81920, T_PROMPT = 65536, DMODEL = 1024, DFF = 2816, INW = 5120;
constexpr float RMS_EPS = 1e-6f;
constexpr float QK_C2 = 0.125f * 1.4426950408889634f;
__device__ __forceinline__ int opaque_tid() { int t = threadIdx.x; asm volatile("" : "+v"(t)); return t; }
__device__ __forceinline__ float xsum16(float v) { const auto r = __builtin_amdgcn_permlane16_swap(__float_as_uint(v), __float_as_uint(v), false, false); return __uint_as_float(r[0]) + __uint_as_float(r[1]); }
__device__ __forceinline__ float xsum32(float v) { const auto r = __builtin_amdgcn_permlane32_swap(__float_as_uint(v), __float_as_uint(v), false, false); return __uint_as_float(r[0]) + __uint_as_float(r[1]); }
__device__ __forceinline__ float xmax32(float v) { const auto r = __builtin_amdgcn_permlane32_swap(__float_as_uint(v), __float_as_uint(v), false, false); return fmaxf(__uint_as_float(r[0]), __uint_as_float(r[1])); }
namespace pg8 {
#define PG8_LAS __attribute__((address_space(3)))
typedef unsigned short bf16_t;
typedef short bf16x8 __attribute__((ext_vector_type(8)));
typedef float f32x4 __attribute__((ext_vector_type(4)));
typedef unsigned u32x4 __attribute__((ext_vector_type(4)));
constexpr int BM = 256, BK = 64, HALF = 128, HTB = HALF * BK * 2  , STAGE_BYTES = 8 * HTB, NXCD = 8, WGM = 8;

__host__ __device__ __forceinline__ int lds_byte(int r, int c) { const int st = (r >> 4) * 2 + (c >> 5), rr = r & 15, cc = c & 31, ob = rr * 64 + cc * 2; return st * 1024 + (ob ^ (((ob >> 9) & 1) << 5)); }
__host__ __device__ __forceinline__ void stage_rc(int b, int& R, int& C) { const int st = b / 1024, sb = b % 1024, swz = sb ^ (((sb >> 9) & 1) << 5); R = (st >> 1) * 16 + swz / 64; C = (st & 1) * 32 + (swz % 64) / 2; }
__host__ __device__ __forceinline__ int perm32(int rho) { const int n = rho >> 4, i = rho & 15; return 8 * (i >> 2) + 4 * n + (i & 3); }

struct Unit { int pm, pn; };
struct Gemm { const bf16_t* A; const bf16_t* Bt; int M, N, K; };

struct StaticOrder {
    int nM, nN, nwg, G, c;
    __host__ __device__ void init(int M, int N, int G_, int c_) { nM = M / BM; nN = N / BM; nwg = nM * nN; G = G_; c = c_; }
    __host__ __device__ bool next(int i, Unit& u) const {
        const long L = (long)i * G + c; if (L >= nwg) return false;
        int wgid = (int)L; { const int q = nwg / NXCD, r = nwg % NXCD, xcd = wgid % NXCD, off = wgid / NXCD; wgid = (xcd < r ? xcd * (q + 1) : r * (q + 1) + (xcd - r) * q) + off; }
        const int nig = WGM * nN, gid = wgid / nig, fm = gid * WGM, gsz = (nM - fm) < WGM ? (nM - fm) : WGM;
        u.pm = fm + ((wgid % nig) % gsz); u.pn = (wgid % nig) / gsz; return true;
    }
    __device__ __forceinline__ void a_ready(const Unit&) const {}
    __device__ __forceinline__ void done(const Unit&) const {}
};

__device__ __forceinline__ unsigned cvt_pk_bf16(float lo, float hi) { unsigned r; asm volatile("v_cvt_pk_bf16_f32 %0, %1, %2" : "=v"(r) : "v"(lo), "v"(hi)); return r; }
typedef unsigned u32x2 __attribute__((ext_vector_type(2)));
__device__ __forceinline__ float bf_lo(unsigned w) { return __uint_as_float(w << 16); }
__device__ __forceinline__ float bf_hi(unsigned w) { return __uint_as_float(w & 0xffff0000u); }
__device__ __forceinline__ float row_rstd(const float* part, int row, int fq) {
    const f32x4 p = *(const f32x4*)(part + (size_t)row * 16 + 4 * fq);
    float s = (p[0] + p[1]) + (p[2] + p[3]);
    s = xsum32(xsum16(s));
    return rsqrtf(s * (1.0f / 1024.0f) + RMS_EPS);
}
__device__ __forceinline__ float sigmoid_f(float v) { return __builtin_amdgcn_rcpf(1.0f + __expf(-v)); }

struct EpiSwiglu {
    static constexpr bool PERM = true, AFTER_DRAIN = false, HAS_INIT = false; static constexpr int MID_T = 0;
    bf16_t* G; const float* part;
    __device__ __forceinline__ void operator()(const f32x4 (&acc)[2][2][4][2], const Unit& u, int wr, int wc, int fr, int fq) const {
        const int row0 = u.pm * BM + wr * 64 + fr, col0 = u.pn * 128 + wc * 32 + 8 * fq;
#pragma unroll
        for (int ai = 0; ai < 2; ++ai)
#pragma unroll
            for (int m = 0; m < 4; ++m) {
                const int row = row0 + ai * HALF + m * 16; const float rs = row_rstd(part, row, fq);
                f32x4 o[2];
#pragma unroll
                for (int n = 0; n < 2; ++n) { const f32x4 a = acc[ai][0][m][n] * rs, b = acc[ai][1][m][n] * rs;
#pragma unroll
                    for (int j = 0; j < 4; ++j) o[n][j] = a[j] * b[j] * sigmoid_f(a[j]); }
                u32x4 w; w.x = cvt_pk_bf16(o[0][0], o[0][1]); w.y = cvt_pk_bf16(o[0][2], o[0][3]); w.z = cvt_pk_bf16(o[1][0], o[1][1]); w.w = cvt_pk_bf16(o[1][2], o[1][3]);
                __builtin_nontemporal_store(w, (u32x4*)(G + (((size_t)u.pm * (DFF / 64) + (col0 >> 6)) * BM + (row - u.pm * BM)) * 64 + (col0 & 63)));
            }
    }
};
template <bool BASE_BF16> struct EpiResid {
    static constexpr bool PERM = true, AFTER_DRAIN = false, HAS_INIT = true, DUP = false; static constexpr int MID_T = 0;
    const float* base0; const float* base1; const bf16_t* bbase; float* out; bf16_t* xb; float* part; float scale, inv_scale;
    __device__ __forceinline__ void init(f32x4 (&acc)[2][2][4][2], const Unit& u, int wr, int wc, int fr, int fq) const {
        const int row0 = u.pm * BM + wr * 64 + fr, col0 = u.pn * BM + wc * 32 + 8 * fq;
        if constexpr (BASE_BF16) {
#pragma unroll
            for (int ai = 0; ai < 2; ++ai)
#pragma unroll
                for (int m = 0; m < 4; ++m) { const bf16_t* bp = bbase + (size_t)(row0 + ai * HALF + m * 16) * DMODEL + col0;
#pragma unroll
                    for (int bj = 0; bj < 2; ++bj) { const u32x4 w = *(const u32x4*)(bp + bj * HALF);
                        acc[ai][bj][m][0] = (f32x4){bf_lo(w.x), bf_hi(w.x), bf_lo(w.y), bf_hi(w.y)} * inv_scale; acc[ai][bj][m][1] = (f32x4){bf_lo(w.z), bf_hi(w.z), bf_lo(w.w), bf_hi(w.w)} * inv_scale; } }
        } else {
        const float* bp0 = (row0 < T_PROMPT) ? base0 + (size_t)row0 * DMODEL : base1 + (size_t)(row0 - T_PROMPT) * DMODEL;
#pragma unroll
        for (int ai = 0; ai < 2; ++ai)
#pragma unroll
            for (int m = 0; m < 4; ++m) { const float* bp = bp0 + (size_t)(ai * HALF + m * 16) * DMODEL + col0;
#pragma unroll
                for (int bj = 0; bj < 2; ++bj)
#pragma unroll
                    for (int n = 0; n < 2; ++n) acc[ai][bj][m][n] = __builtin_nontemporal_load((const f32x4*)(bp + bj * HALF + 4 * n)) * inv_scale; }
        }
    }
    __device__ __forceinline__ void operator()(const f32x4 (&acc)[2][2][4][2], const Unit& u, int wr, int wc, int fr, int fq) const {
        const int row0 = u.pm * BM + wr * 64 + fr, col0 = u.pn * BM + wc * 32 + 8 * fq;
#pragma unroll
        for (int ai = 0; ai < 2; ++ai)
#pragma unroll
            for (int m = 0; m < 4; ++m) {
                const int row = row0 + ai * HALF + m * 16;
                float ss = 0.f;
#pragma unroll
                for (int bj = 0; bj < 2; ++bj) { const int c = col0 + bj * HALF;
                    const f32x4 v0 = acc[ai][bj][m][0] * scale, v1 = acc[ai][bj][m][1] * scale;
                    if (out) { *(f32x4*)(out + (size_t)row * DMODEL + c) = v0; *(f32x4*)(out + (size_t)row * DMODEL + c + 4) = v1; }
                    ss += (v0[0] * v0[0] + v0[1] * v0[1]) + (v0[2] * v0[2] + v0[3] * v0[3]) + (v1[0] * v1[0] + v1[1] * v1[1]) + (v1[2] * v1[2] + v1[3] * v1[3]);
                    if (xb) { u32x4 w; w.x = cvt_pk_bf16(v0[0], v0[1]); w.y = cvt_pk_bf16(v0[2], v0[3]); w.z = cvt_pk_bf16(v1[0], v1[1]); w.w = cvt_pk_bf16(v1[2], v1[3]);
                        *(u32x4*)(xb + (size_t)row * DMODEL + c) = w; } }
                ss = xsum32(xsum16(ss));
                if (fq == 0) part[(size_t)row * 16 + u.pn * 4 + wc] = ss;
            }
    }
};
struct EpiGate2 {
    static constexpr bool PERM = true, AFTER_DRAIN = false, HAS_INIT = false, DUP = false; static constexpr int MID_T = 4;
    const bf16_t* ga; const bf16_t* gb; bf16_t* out;
    __device__ __forceinline__ void mid(f32x4 (&acc)[2][2][4][2], const Unit& u, int wr, int wc, int fr, int fq) const {
        int oz = 0; asm volatile("" : "+v"(oz));
        const int row0 = u.pm * BM + wr * 64 + fr + oz, col0 = u.pn * BM + wc * 32 + 8 * fq;
#pragma unroll
        for (int ai = 0; ai < 2; ++ai)
#pragma unroll
            for (int m = 0; m < 4; ++m)
#pragma unroll
                for (int bj = 0; bj < 2; ++bj) { const size_t off = (size_t)(row0 + ai * HALF + m * 16) * DMODEL + col0 + bj * HALF;
                    const u32x4 aw = *(const u32x4*)(ga + off), bw = *(const u32x4*)(gb + off);
                    const float a0 = fmaxf(bf_lo(aw.x), 1e-30f), a1 = fmaxf(bf_hi(aw.x), 1e-30f), a2 = fmaxf(bf_lo(aw.y), 1e-30f), a3 = fmaxf(bf_hi(aw.y), 1e-30f);
                    const float a4 = fmaxf(bf_lo(aw.z), 1e-30f), a5 = fmaxf(bf_hi(aw.z), 1e-30f), a6 = fmaxf(bf_lo(aw.w), 1e-30f), a7 = fmaxf(bf_hi(aw.w), 1e-30f);
                    f32x4 v0 = acc[ai][bj][m][0], v1 = acc[ai][bj][m][1];
                    v0[0] *= bf_lo(bw.x) * __builtin_amdgcn_rcpf(a0); v0[1] *= bf_hi(bw.x) * __builtin_amdgcn_rcpf(a1); v0[2] *= bf_lo(bw.y) * __builtin_amdgcn_rcpf(a2); v0[3] *= bf_hi(bw.y) * __builtin_amdgcn_rcpf(a3);
                    v1[0] *= bf_lo(bw.z) * __builtin_amdgcn_rcpf(a4); v1[1] *= bf_hi(bw.z) * __builtin_amdgcn_rcpf(a5); v1[2] *= bf_lo(bw.w) * __builtin_amdgcn_rcpf(a6); v1[3] *= bf_hi(bw.w) * __builtin_amdgcn_rcpf(a7);
                    acc[ai][bj][m][0] = v0; acc[ai][bj][m][1] = v1;
                    if (bj == 1) asm volatile("" ::: "memory"); }
    }
    __device__ __forceinline__ void operator()(const f32x4 (&acc)[2][2][4][2], const Unit& u, int wr, int wc, int fr, int fq) const {
        const int row0 = u.pm * BM + wr * 64 + fr, col0 = u.pn * BM + wc * 32 + 8 * fq;
#pragma unroll
        for (int ai = 0; ai < 2; ++ai)
#pragma unroll
            for (int m = 0; m < 4; ++m)
#pragma unroll
                for (int bj = 0; bj < 2; ++bj) { const size_t off = (size_t)(row0 + ai * HALF + m * 16) * DMODEL + col0 + bj * HALF;
                    const u32x4 aw = *(const u32x4*)(ga + off);
                    f32x4 v0 = acc[ai][bj][m][0], v1 = acc[ai][bj][m][1];
                    v0[0] *= fmaxf(bf_lo(aw.x), 1e-30f); v0[1] *= fmaxf(bf_hi(aw.x), 1e-30f); v0[2] *= fmaxf(bf_lo(aw.y), 1e-30f); v0[3] *= fmaxf(bf_hi(aw.y), 1e-30f);
                    v1[0] *= fmaxf(bf_lo(aw.z), 1e-30f); v1[1] *= fmaxf(bf_hi(aw.z), 1e-30f); v1[2] *= fmaxf(bf_lo(aw.w), 1e-30f); v1[3] *= fmaxf(bf_hi(aw.w), 1e-30f);
                    u32x4 w; w.x = cvt_pk_bf16(v0[0], v0[1]); w.y = cvt_pk_bf16(v0[2], v0[3]); w.z = cvt_pk_bf16(v1[0], v1[1]); w.w = cvt_pk_bf16(v1[2], v1[3]);
                    *(u32x4*)(out + off) = w; }
    }
};
struct EpiProj {
    static constexpr bool PERM = false, AFTER_DRAIN = false, HAS_INIT = false, DUP = false; static constexpr int MID_T = 0;
    bf16_t *QA, *KA, *VA, *QB, *KB, *VB, *GA, *GB; const float *cosA, *sinA, *cosB, *sinB, *qkn, *part;
    __device__ __forceinline__ void operator()(const f32x4 (&acc)[2][2][4][2], const Unit& u, int wr, int wc, int fr, int fq) const {
        const int pn = u.pn; int kind; bf16_t* dst; int pitch, colbase, hB = -1;
        if (pn < 2) { kind = 0; dst = QA; pitch = 512; colbase = (pn * 4 + wc) * 64; }
        else if (pn == 2) { if (wc < 2) { kind = 1; dst = KA; pitch = 128; colbase = wc * 64; } else { kind = 4; dst = VA; pitch = 128; colbase = (wc - 2) * 64; } }
        else if (pn < 6) { kind = 2; dst = QB; hB = (pn - 3) * 4 + wc; pitch = 64; colbase = 0; }
        else if (pn < 9) { kind = 3; dst = KB; hB = (pn - 6) * 4 + wc; pitch = 64; colbase = 0; }
        else if (pn < 12) { kind = 4; dst = VB; hB = (pn - 9) * 4 + wc; pitch = 64; colbase = 0; }
        else if (pn < 16) { kind = 5; dst = GA; pitch = 1024; colbase = (pn - 12) * 256 + wc * 64; }
        else { kind = 5; dst = GB; pitch = 1024; colbase = (pn - 16) * 256 + wc * 64; }
        const int row0 = u.pm * BM + wr * 64 + fr;
        const int S = (row0 < T_PROMPT) ? 4096 : 8192;
        const int sh = hB >= 0 ? 2 * (hB >> 2) : 0;
        float rsv[8];
#pragma unroll
        for (int i = 0; i < 8; ++i) rsv[i] = row_rstd(part, row0 + (i >> 2) * HALF + (i & 3) * 16, fq);
#pragma unroll
        for (int ai = 0; ai < 2; ++ai)
#pragma unroll
            for (int m = 0; m < 4; ++m) {
                const int row = row0 + ai * HALF + m * 16; const float rs = rsv[ai * 4 + m];
                const int t = row & (S - 1);
                f32x4 v[2][2];
#pragma unroll
                for (int bj = 0; bj < 2; ++bj)
#pragma unroll
                    for (int n = 0; n < 2; ++n) v[bj][n] = acc[ai][bj][m][n] * rs;
                if (kind <= 1) {
                    const float* gp = qkn + kind * 64;
                    float ss = 0.f;
#pragma unroll
                    for (int bj = 0; bj < 2; ++bj)
#pragma unroll
                        for (int n = 0; n < 2; ++n) ss += (v[bj][n][0] * v[bj][n][0] + v[bj][n][1] * v[bj][n][1]) + (v[bj][n][2] * v[bj][n][2] + v[bj][n][3] * v[bj][n][3]);
                    ss = xsum32(xsum16(ss));
                    const float hr = rsqrtf(ss * (1.0f / 64.0f) + RMS_EPS) * (kind == 0 ? QK_C2 : 1.0f);
#pragma unroll
                    for (int bj = 0; bj < 2; ++bj) { const int pos = bj == 0 ? (t >> 6) : (t & 63);
                        const f32x4 c = *(const f32x4*)(cosA + pos * 16 + 4 * fq), s = *(const f32x4*)(sinA + pos * 16 + 4 * fq);
                        const f32x4 x1 = v[bj][0] * *(const f32x4*)(gp + 32 * bj + 4 * fq) * hr, x2 = v[bj][1] * *(const f32x4*)(gp + 32 * bj + 16 + 4 * fq) * hr;
                        v[bj][0] = x1 * c - x2 * s; v[bj][1] = x2 * c + x1 * s; }
                } else if (kind <= 3) {
                    const int fi = fq < 2 ? fq : 0;
                    f32x4 c = *(const f32x4*)(cosB + t * 8 + 4 * fi), s = *(const f32x4*)(sinB + t * 8 + 4 * fi);
                    if (fq >= 2) { c = (f32x4){1.f, 1.f, 1.f, 1.f}; s = (f32x4){0.f, 0.f, 0.f, 0.f}; }
                    const f32x4 x1 = v[0][0], x2 = v[0][1];
                    v[0][0] = x1 * c - x2 * s; v[0][1] = x2 * c + x1 * s;
                    if (kind == 2) {
#pragma unroll
                        for (int bj = 0; bj < 2; ++bj)
#pragma unroll
                            for (int n = 0; n < 2; ++n) v[bj][n] = v[bj][n] * QK_C2; }
                } else if (kind == 5) {
#pragma unroll
                    for (int bj = 0; bj < 2; ++bj)
#pragma unroll
                        for (int n = 0; n < 2; ++n)
#pragma unroll
                            for (int j = 0; j < 4; ++j) v[bj][n][j] = sigmoid_f(v[bj][n][j]);
                }
                size_t roff;
                if (hB >= 0) { const int perm = (t & ((1 << sh) - 1)) * (S >> sh) + (t >> sh); roff = ((size_t)hB * T_ROWS + (size_t)(row - t) + perm) * 64; }
                else roff = (size_t)row * pitch + colbase;
                bf16_t* rp = dst + roff + 8 * fq;
#pragma unroll
                for (int bj = 0; bj < 2; ++bj) { u32x4 w; w.x = cvt_pk_bf16(v[bj][0][0], v[bj][0][1]); w.y = cvt_pk_bf16(v[bj][0][2], v[bj][0][3]); w.z = cvt_pk_bf16(v[bj][1][0], v[bj][1][1]); w.w = cvt_pk_bf16(v[bj][1][2], v[bj][1][3]);
                    *(u32x4*)(rp + 32 * bj) = w; }
            }
    }
};
template <class Epi, class Sched, bool ALIGN_EPI = false, bool SP2 = false, bool ATILED = false>
__device__ __forceinline__ void gemm_phase(PG8_LAS unsigned char* lds, const Gemm g, const Sched& S, const Epi& E) {
    const int tid = opaque_tid(), wid = __builtin_amdgcn_readfirstlane(tid >> 6), lane = tid & 63, wr = wid >> 2, wc = wid & 3, fr = lane & 15, fq = lane >> 4;
    const int K = g.K, nt = K / BK;
    unsigned voffA[2], voffB[2];
#pragma unroll
    for (int i = 0; i < 2; ++i) { int R, C; stage_rc(tid * 16 + i * 8192, R, C); const int Rb = Epi::PERM ? ((R & ~31) + perm32(R & 31)) : R;
        voffA[i] = (unsigned)(R * (ATILED ? BK : K) + C) * 2u; voffB[i] = (unsigned)(Rb * K + C) * 2u; }
    const size_t kstep = (size_t)(BK * 2);
    const size_t hstep = (size_t)HALF * K * 2;
    const size_t kstepA = ATILED ? (size_t)BM * BK * 2 : kstep, hstepA = ATILED ? (size_t)HALF * BK * 2 : hstep;
    const size_t tstep = 2 * hstep;
    const unsigned ldsw = (unsigned)wid * 1024u;
    const int aoff = lds_byte(wr * 64 + fr, fq * 8), boff = lds_byte(wc * 32 + fr, fq * 8);
#define PG8_SA(b, h) (((b) * 2 + (h)) * HTB)
#define PG8_SB(b, h) ((4 + (b) * 2 + (h)) * HTB)
#define PG8_STAGE(bufoff, gbase, voff) do { _Pragma("unroll") for (int _i = 0; _i < 2; ++_i) \
        __builtin_amdgcn_global_load_lds((const unsigned*)((const char*)(gbase) + (voff)[_i]), (PG8_LAS unsigned*)(lds + (bufoff) + ldsw + _i * 8192), 16, 0, 0); } while (0)
#define PG8_LDA(dst, b, h) do { _Pragma("unroll") for (int m = 0; m < 4; ++m) _Pragma("unroll") for (int k = 0; k < 2; ++k) dst[m][k] = *(const PG8_LAS bf16x8*)(lds + PG8_SA(b, h) + aoff + m * 2048 + k * 1024); } while (0)
#define PG8_LDB(dst, b, h) do { _Pragma("unroll") for (int n = 0; n < 2; ++n) _Pragma("unroll") for (int k = 0; k < 2; ++k) dst[n][k] = *(const PG8_LAS bf16x8*)(lds + PG8_SB(b, h) + boff + n * 2048 + k * 1024); } while (0)
#define PG8_MMA(ai, bj, At, Bt) do { __builtin_amdgcn_s_setprio(1); _Pragma("unroll") for (int m = 0; m < 4; ++m) _Pragma("unroll") for (int n = 0; n < 2; ++n) _Pragma("unroll") for (int k = 0; k < 2; ++k) \
        acc[ai][bj][m][n] = __builtin_amdgcn_mfma_f32_16x16x32_bf16(Bt[n][k], At[m][k], acc[ai][bj][m][n], 0, 0, 0); __builtin_amdgcn_s_setprio(0); } while (0)
#define PG8_WAIT_V(n) asm volatile("s_waitcnt vmcnt(" #n ")" ::: "memory")
#define PG8_WAIT_L(n) asm volatile("s_waitcnt lgkmcnt(" #n ")" ::: "memory")
#define PG8_BAR __builtin_amdgcn_s_barrier()
#define PG8_SCHED __builtin_amdgcn_sched_barrier(0)
    Unit cur, nxt; int ui = 0;
    if (!S.next(0, cur)) return;
    f32x4 acc[2][2][4][2];
    if constexpr (Epi::HAS_INIT) E.init(acc, cur, wr, wc, fr, fq);
    else {
#pragma unroll
    for (int a = 0; a < 2; ++a)
#pragma unroll
        for (int b = 0; b < 2; ++b)
#pragma unroll
            for (int m = 0; m < 4; ++m)
#pragma unroll
                for (int n = 0; n < 2; ++n) acc[a][b][m][n] = (f32x4){0.f, 0.f, 0.f, 0.f};
    }
    bf16x8 At[4][2], B0[2][2], B1[2][2];
    const char* cA = (const char*)g.A + (size_t)cur.pm * tstep; const char* cB = (const char*)g.Bt + (size_t)cur.pn * tstep;
    S.a_ready(cur);
    if constexpr (SP2) {
        PG8_STAGE(PG8_SB(0, 0), cB, voffB); PG8_STAGE(PG8_SB(0, 1), cB + hstep, voffB); PG8_STAGE(PG8_SA(0, 0), cA, voffA); PG8_STAGE(PG8_SA(0, 1), cA + hstepA, voffA);
        if (wr == 1) PG8_BAR;
        PG8_WAIT_V(2); PG8_BAR;
        PG8_STAGE(PG8_SB(1, 0), cB + kstep, voffB); PG8_STAGE(PG8_SA(1, 0), cA + kstepA, voffA); PG8_STAGE(PG8_SB(1, 1), cB + hstep + kstep, voffB);
        PG8_WAIT_V(6); PG8_BAR;
    } else {
        PG8_STAGE(PG8_SB(0, 0), cB, voffB); PG8_STAGE(PG8_SA(0, 0), cA, voffA); PG8_STAGE(PG8_SB(0, 1), cB + hstep, voffB); PG8_STAGE(PG8_SA(0, 1), cA + hstepA, voffA);
        if (wr == 1) PG8_BAR;
        PG8_WAIT_V(4); PG8_BAR;
        PG8_STAGE(PG8_SB(1, 0), cB + kstep, voffB); PG8_STAGE(PG8_SA(1, 0), cA + kstepA, voffA); PG8_STAGE(PG8_SB(1, 1), cB + hstep + kstep, voffB);
        PG8_WAIT_V(6); PG8_BAR;
    }
    for (;;) {
        const bool has_next = S.next(ui + 1, nxt);
        const char* nA = has_next ? (const char*)g.A + (size_t)nxt.pm * tstep : cA; const char* nB = has_next ? (const char*)g.Bt + (size_t)nxt.pn * tstep : cB;
        for (int t = 0; t < nt; t += 2) {
            if constexpr (Epi::MID_T > 0) { if (t == Epi::MID_T) E.mid(acc, cur, wr, wc, fr, fq); }
            const bool last = (t == nt - 2);
            const char* a1 = cA + (size_t)(t + 1) * kstepA;
            const char* a2 = last ? nA : cA + (size_t)(t + 2) * kstepA; const char* b2 = last ? nB : cB + (size_t)(t + 2) * kstep;
            const char* a3 = a2 + kstepA; const char* b3 = b2 + kstep;
            if (last && has_next) S.a_ready(nxt);
            if constexpr (SP2) {
            PG8_LDB(B0, 0, 0); PG8_LDB(B1, 0, 1); PG8_SCHED; PG8_LDA(At, 0, 0); PG8_STAGE(PG8_SA(1, 1), a1 + hstepA, voffA);
            PG8_WAIT_V(8); PG8_WAIT_L(0); PG8_BAR; PG8_MMA(0, 0, At, B0); PG8_MMA(0, 1, At, B1); PG8_BAR; PG8_SCHED;
            PG8_LDA(At, 0, 1); PG8_STAGE(PG8_SB(0, 0), b2, voffB); PG8_STAGE(PG8_SB(0, 1), b2 + hstep, voffB); PG8_STAGE(PG8_SA(0, 0), a2, voffA);
            PG8_WAIT_V(8); PG8_WAIT_L(0); PG8_BAR; PG8_MMA(1, 0, At, B0); PG8_MMA(1, 1, At, B1); PG8_BAR; PG8_SCHED;
            PG8_LDB(B0, 1, 0); PG8_LDB(B1, 1, 1); PG8_SCHED; PG8_LDA(At, 1, 0); PG8_STAGE(PG8_SA(0, 1), a2 + hstepA, voffA);
            PG8_WAIT_V(8); PG8_WAIT_L(0); PG8_BAR; PG8_MMA(0, 0, At, B0); PG8_MMA(0, 1, At, B1); PG8_BAR; PG8_SCHED;
            PG8_LDA(At, 1, 1); PG8_STAGE(PG8_SB(1, 0), b3, voffB); PG8_STAGE(PG8_SB(1, 1), b3 + hstep, voffB); PG8_STAGE(PG8_SA(1, 0), a3, voffA);
            PG8_WAIT_V(8); PG8_WAIT_L(0); PG8_BAR; PG8_MMA(1, 0, At, B0); PG8_MMA(1, 1, At, B1); PG8_BAR; PG8_SCHED;
            } else {
            PG8_LDB(B0, 0, 0); PG8_SCHED; PG8_LDA(At, 0, 0); PG8_STAGE(PG8_SA(1, 1), a1 + hstepA, voffA);
            PG8_WAIT_L(8); PG8_BAR; PG8_WAIT_L(0); PG8_MMA(0, 0, At, B0); PG8_BAR; PG8_SCHED;
            PG8_LDB(B1, 0, 1); PG8_STAGE(PG8_SB(0, 0), b2, voffB);
            PG8_BAR; PG8_WAIT_L(0); PG8_MMA(0, 1, At, B1); PG8_BAR;
            PG8_LDA(At, 0, 1); PG8_STAGE(PG8_SA(0, 0), a2, voffA);
            PG8_BAR; PG8_WAIT_L(0); PG8_MMA(1, 0, At, B0); PG8_BAR; PG8_SCHED;
            PG8_STAGE(PG8_SB(0, 1), b2 + hstep, voffB);
            PG8_WAIT_V(6); PG8_BAR; PG8_MMA(1, 1, At, B1); PG8_BAR;
            PG8_LDB(B0, 1, 0); PG8_SCHED; PG8_LDA(At, 1, 0); PG8_STAGE(PG8_SA(0, 1), a2 + hstepA, voffA);
            PG8_WAIT_L(8); PG8_BAR; PG8_WAIT_L(0); PG8_MMA(0, 0, At, B0); PG8_BAR; PG8_SCHED;
            PG8_LDB(B1, 1, 1); PG8_STAGE(PG8_SB(1, 0), b3, voffB);
            PG8_BAR; PG8_WAIT_L(0); PG8_MMA(0, 1, At, B1); PG8_BAR;
            PG8_LDA(At, 1, 1); PG8_STAGE(PG8_SA(1, 0), a3, voffA);
            PG8_BAR; PG8_WAIT_L(0); PG8_MMA(1, 0, At, B0); PG8_BAR; PG8_SCHED;
            PG8_STAGE(PG8_SB(1, 1), b3 + hstep, voffB);
            PG8_WAIT_V(6); PG8_BAR; PG8_MMA(1, 1, At, B1); PG8_BAR;
            }
        }
        if constexpr (ALIGN_EPI) { if (wr == 0) PG8_BAR; }
        if constexpr (!Epi::AFTER_DRAIN) { E(acc, cur, wr, wc, fr, fq); S.done(cur); }
        if (!has_next) break;
        if constexpr (Epi::HAS_INIT) E.init(acc, nxt, wr, wc, fr, fq);
        else {
#pragma unroll
        for (int a = 0; a < 2; ++a)
#pragma unroll
            for (int b = 0; b < 2; ++b)
#pragma unroll
                for (int m = 0; m < 4; ++m)
#pragma unroll
                    for (int n = 0; n < 2; ++n) acc[a][b][m][n] = (f32x4){0.f, 0.f, 0.f, 0.f};
        }
        cur = nxt; cA = nA; cB = nB; ++ui;
        if constexpr (ALIGN_EPI) { if (wr == 1) PG8_BAR; }
    }
    PG8_WAIT_V(0);
    if constexpr (!ALIGN_EPI) { if (wr == 0) PG8_BAR; }
    PG8_BAR;
    if constexpr (Epi::AFTER_DRAIN) { E.fused(acc, cur, wr, wc, fr, fq, lds, wid, lane); S.done(cur); }
#undef PG8_SA
#undef PG8_SB
#undef PG8_STAGE
#undef PG8_LDA
#undef PG8_LDB
#undef PG8_MMA
#undef PG8_WAIT_V
#undef PG8_WAIT_L
#undef PG8_BAR
#undef PG8_SCHED
}
}
#include <hip/hip_bf16.h>
#include <cmath>
namespace attn_body {
using bf16=__hip_bfloat16;
using bf16x8=__attribute__((ext_vector_type(8)))short;
using s16x4=__attribute__((ext_vector_type(4)))short;
using f32x16=__attribute__((ext_vector_type(16)))float;
using u32x4=__attribute__((ext_vector_type(4)))unsigned;
constexpr int D=64,QP=512,KP=128,OPT=768,OCOL=256;
constexpr int NW=8,QBLK=32,QB=QBLK*NW,KVBLK=64;

__device__ __forceinline__ int crow(int r,int hi){return (r&3)+8*(r>>2)+4*hi;}
#define SBAR() __builtin_amdgcn_sched_barrier(0)
__device__ __forceinline__ void cmask(f32x16&p0,f32x16&p1,int jb,int qrel,int hi){
  const float NEG=-INFINITY; int kb=64*jb+4*hi;
  #pragma unroll
  for(int r=0;r<16;++r){int kv=kb+(r&3)+8*(r>>2); if(kv>qrel)p0[r]=NEG; if(kv+32>qrel)p1[r]=NEG;}
}

constexpr int NSLOT=3, SLOTB=8192;
constexpr int LDS_K=0, LDS_V=NSLOT*SLOTB, LDS_WS=2*NSLOT*SLOTB, LDS_OST=LDS_WS+NW*64*4, LDS_BYTES=LDS_OST+NW*4096;
constexpr float C2=0.125f*1.4426950408889634f;
__device__ __forceinline__ void glds16(const void*gsrc,unsigned lds_dst){unsigned keep;
  asm volatile("s_mov_b32 %0, m0\n\ts_mov_b32 m0, %2\n\ts_nop 0\n\tglobal_load_lds_dwordx4 %1, off\n\ts_mov_b32 m0, %0":"=&s"(keep):"v"(gsrc),"s"(lds_dst):"memory");}
__device__ __forceinline__ float max3f(float a,float b,float c){float r;asm("v_max3_f32 %0, %1, %2, %3":"=v"(r):"v"(a),"v"(b),"v"(c));return r;}
__device__ __forceinline__ float max2f(float a,float b){float r;asm("v_max_f32_e32 %0, %1, %2":"=v"(r):"v"(a),"v"(b));return r;}
__device__ __forceinline__ float fadd_s(float a,float b){float r;asm("v_add_f32_e32 %0, %1, %2":"=v"(r):"v"(a),"v"(b));return r;}
__device__ __forceinline__ float fsub_s(float a,float b){float r;asm("v_sub_f32_e32 %0, %1, %2":"=v"(r):"v"(a),"v"(b));return r;}
typedef float f32x2_t __attribute__((ext_vector_type(2))); typedef __bf16 bf16x2_t __attribute__((ext_vector_type(2)));
__device__ __forceinline__ unsigned cvtpk_s(float lo,float hi){f32x2_t v={lo,hi};bf16x2_t b=__builtin_convertvector(v,bf16x2_t);return __builtin_bit_cast(unsigned,b);}
#define WAIT_BAR(N) asm volatile("s_waitcnt vmcnt(" #N ") lgkmcnt(0)\n\ts_barrier":::"memory")

__device__ __forceinline__ void qkt(f32x16&p0,f32x16&p1,const char*Kslot,const bf16x8*qr,const f32x16&negm,int r32,int hi){
  const char*kb=Kslot+hi*1024+r32*16;
  #pragma unroll
  for(int d0=0;d0<4;++d0){
    const bf16x8 b0=*reinterpret_cast<const bf16x8*>(kb+d0*2048);
    const bf16x8 b1=*reinterpret_cast<const bf16x8*>(kb+d0*2048+512);
    if(d0==0){p0=__builtin_amdgcn_mfma_f32_32x32x16_bf16(b0,qr[0],negm,0,0,0);p1=__builtin_amdgcn_mfma_f32_32x32x16_bf16(b1,qr[0],negm,0,0,0);}
    else{p0=__builtin_amdgcn_mfma_f32_32x32x16_bf16(b0,qr[d0],p0,0,0,0);p1=__builtin_amdgcn_mfma_f32_32x32x16_bf16(b1,qr[d0],p1,0,0,0);}}
}
typedef __attribute__((address_space(3))) const char* lds_cptr;
typedef short v4i16_t __attribute__((ext_vector_type(4)));
__device__ __forceinline__ void kload8(bf16x8*kf,lds_cptr kp){
  kf[0]=*(const __attribute__((address_space(3))) bf16x8*)(kp);      kf[1]=*(const __attribute__((address_space(3))) bf16x8*)(kp+512);
  kf[2]=*(const __attribute__((address_space(3))) bf16x8*)(kp+2048); kf[3]=*(const __attribute__((address_space(3))) bf16x8*)(kp+2560);
  kf[4]=*(const __attribute__((address_space(3))) bf16x8*)(kp+4096); kf[5]=*(const __attribute__((address_space(3))) bf16x8*)(kp+4608);
  kf[6]=*(const __attribute__((address_space(3))) bf16x8*)(kp+6144); kf[7]=*(const __attribute__((address_space(3))) bf16x8*)(kp+6656);
}
__device__ __forceinline__ void kload2(bf16x8*kf,lds_cptr kp,int j){ kf[2*j]=*(const __attribute__((address_space(3))) bf16x8*)(kp+j*2048); kf[2*j+1]=*(const __attribute__((address_space(3))) bf16x8*)(kp+j*2048+512); }
__device__ __forceinline__ s16x4 vtr(lds_cptr p){ return __builtin_bit_cast(s16x4,__builtin_amdgcn_ds_read_tr16_b64_v4i16((__attribute__((address_space(3))) v4i16_t*)p)); }
__device__ __forceinline__ float rowmax(const f32x16&p0,const f32x16&p1){
  float a=max3f(p0[0],p0[1],p1[0]),b=max3f(p0[2],p0[3],p1[1]);a=max3f(a,p1[2],p1[3]);
  #pragma unroll
  for(int r=4;r<16;r+=4){a=max3f(a,p0[r],p0[r+1]);b=max3f(b,p0[r+2],p0[r+3]);a=max3f(a,p1[r],p1[r+1]);b=max3f(b,p1[r+2],p1[r+3]);}
  const float m=max2f(a,b);
  auto rr=__builtin_amdgcn_permlane32_swap(__float_as_uint(m),__float_as_uint(m),false,false);
  return max2f(__uint_as_float(rr[0]),__uint_as_float(rr[1]));
}
__device__ __forceinline__ void pv(f32x16*o,int vb,bf16x8 pa0,bf16x8 pa1,bf16x8 pa2,bf16x8 pa3){
  #pragma unroll
  for(int d0=0;d0<2;++d0){s16x4 lo[4],hi[4];
    #pragma unroll
    for(int ks=0;ks<4;++ks){
      asm volatile("ds_read_b64_tr_b16 %0,%1 offset:%c2":"=&v"(lo[ks]):"v"(vb),"i"(d0*4096+ks*1024):"memory");
      asm volatile("ds_read_b64_tr_b16 %0,%1 offset:%c2":"=&v"(hi[ks]):"v"(vb),"i"(d0*4096+ks*1024+512):"memory");}
    asm volatile("s_waitcnt lgkmcnt(0)":::"memory");SBAR();
    #define PK(k) (bf16x8){lo[k][0],lo[k][1],lo[k][2],lo[k][3],hi[k][0],hi[k][1],hi[k][2],hi[k][3]}
    o[d0]=__builtin_amdgcn_mfma_f32_32x32x16_bf16(pa0,PK(0),o[d0],0,0,0);
    o[d0]=__builtin_amdgcn_mfma_f32_32x32x16_bf16(pa1,PK(1),o[d0],0,0,0);
    o[d0]=__builtin_amdgcn_mfma_f32_32x32x16_bf16(pa2,PK(2),o[d0],0,0,0);
    o[d0]=__builtin_amdgcn_mfma_f32_32x32x16_bf16(pa3,PK(3),o[d0],0,0,0);
    #undef PK
  }
}

#ifndef ATTN_STORE16
#define ATTN_STORE16(p,v) (*(u32x4*)(p)=(v))
#endif
template<int THRL> __device__ __forceinline__ void attn_unit(long rowbase,int S,int h,int q0,const bf16*Q,const bf16*__restrict__ K,const bf16*__restrict__ V,bf16*O,char*shm){
  const int tid=opaque_tid(),lane=tid&63,r32=lane&31,hi=lane>>5; const int wid=__builtin_amdgcn_readfirstlane(tid>>6);
  const int hk=h>>2;
  const bf16*Qw=Q+(rowbase+q0+wid*QBLK)*QP+h*D;
  const bf16*Kh=K+rowbase*KP+hk*D,*Vh=V+rowbase*KP+hk*D;
  const unsigned lds0=(unsigned)(uintptr_t)shm;
  float*wsf=(float*)(shm+LDS_WS)+wid*64;
  const bf16*ksrc=Kh+(long)lane*KP+wid*8;
  const bf16*vsrc=Vh+(long)(16*(wid&3)+(lane>>2))*KP+(wid>>2)*32+(lane&3)*8;
  const unsigned kdst=lds0+LDS_K+wid*1024, vdst=lds0+LDS_V+wid*1024;
  #define DMA_K(t,slot) glds16(ksrc+(long)(t)*KVBLK*KP,(unsigned)__builtin_amdgcn_readfirstlane(kdst+(slot)))
  #define DMA_V(t,slot) glds16(vsrc+(long)(t)*KVBLK*KP,(unsigned)__builtin_amdgcn_readfirstlane(vdst+(slot)))
  const int vb0=(int)(lds0+LDS_V)+((lane>>4)&1)*32+(lane&3)*8+(4*hi+((lane&15)>>2))*64;
  const char*Kbase=shm+LDS_K; bf16x8 kf[8];
  const lds_cptr shm3=(lds_cptr)shm; const lds_cptr kp0=shm3+LDS_K+hi*1024+r32*16; const lds_cptr vp0=shm3+LDS_V+((lane>>4)&1)*32+(lane&3)*8+(4*hi+((lane&15)>>2))*64;
  const int NT=S/KVBLK;
  DMA_K(0,0);DMA_V(0,0);DMA_K(1,SLOTB);
  bf16x8 qr[4];
  #pragma unroll
  for(int d0=0;d0<4;++d0)qr[d0]=*reinterpret_cast<const bf16x8*>(&Qw[(long)r32*QP+d0*16+hi*8]);
  float mhat=0.f,l_reg=0.f;f32x16 o[2];o[0]=f32x16{};o[1]=f32x16{};f32x16 negm=f32x16{};asm volatile("":"+v"(negm));
  const int qrel=wid*QBLK+r32;
  #define CMASK(P0,P1,t) do{}while(0)
  bool resc=false;
  #define START(P0,P1) do{ const float rm=rowmax(P0,P1); resc=false; \
    { const float dl=rm; mhat=fadd_s(mhat,dl); \
      _Pragma("unroll") for(int r=0;r<16;++r){P0[r]=fsub_s(P0[r],dl);P1[r]=fsub_s(P1[r],dl);} \
      _Pragma("unroll") for(int r=0;r<16;++r)negm[r]=-mhat; asm volatile("":"+v"(negm)); } \
    _Pragma("unroll") for(int r=0;r<16;++r)P0[r]=__builtin_amdgcn_exp2f(P0[r]); }while(0)
  #define RESC() do{ if(resc){ asm volatile("s_waitcnt lgkmcnt(0)":::"memory"); \
      _Pragma("unroll") for(int d_=0;d_<2;++d_) _Pragma("unroll") for(int r=0;r<16;++r)o[d_][r]*=wsf[crow(r,hi)]; } }while(0)
  f32x16 pA0,pA1,pB0,pB1;
  int sl_prev=0,sl_cur=0,sl_next=SLOTB;
  #define ROT() do{sl_prev=sl_cur;sl_cur=sl_next;sl_next=(sl_next==(NSLOT-1)*SLOTB)?0:sl_next+SLOTB;}while(0)
  DMA_K(2,2*SLOTB);
  WAIT_BAR(3);
  qkt(pA0,pA1,Kbase,qr,negm,r32,hi);asm volatile("s_nop 15\n\ts_nop 7":"+v"(pA0),"+v"(pA1));CMASK(pA0,pA1,0);
  START(pA0,pA1);
  _Pragma("unroll") for(int r=0;r<16;++r)pA1[r]=__builtin_amdgcn_exp2f(pA1[r]);
  WAIT_BAR(0);
  DMA_K(3,0);DMA_V(1,SLOTB);
  ROT();
  kload8(kf,kp0+sl_cur);
  WAIT_BAR(2);
  s16x4 vlo[8],vhi[8]; u32x4 pw0,pw1,pw2,pw3;
  #define PKW(P,B) cvtpk_s(P[B],P[B+1])
  #define PAF(k) __builtin_bit_cast(bf16x8,pw##k)
  #define VFR(i) (bf16x8){vlo[i][0],vlo[i][1],vlo[i][2],vlo[i][3],vhi[i][0],vhi[i][1],vhi[i][2],vhi[i][3]}
  #define PIN(x) asm volatile("":"+v"(x))
  #define MX3(a,b,c) __builtin_fmaxf(__builtin_fmaxf((a),(b)),(c))
  #define GAPA(MF,A0,A1,A2,A3,W0,W1,PW) do{ MF; sacc+=A0; sacc+=A1; sacc+=A2; sacc+=A3; PIN(sacc); W0; W1; PIN(PW); SBAR(); }while(0)
  #define EX(v) __builtin_amdgcn_exp2f(v)
  #define GAPB(MF,X,B) do{ MF; X[B]=EX(X[B]); X[B+1]=EX(X[B+1]); X[B+2]=EX(X[B+2]); X[B+3]=EX(X[B+3]); PIN(X); SBAR(); }while(0)
  #define VRD(i) do{ vlo[i]=vtr(vp_+(((i)>>2)*4096+((i)&3)*1024)); vhi[i]=vtr(vp_+(((i)>>2)*4096+((i)&3)*1024+512)); }while(0)
  #define KRD(G,j) do{ if(G){ kload2(kf,kp0+sl_next,j); SBAR(); } }while(0)
  #define STEP(C0,C1,P0,P1,t,GK,GV,GL) do{ SBAR(); \
    const lds_cptr vp_=vp0+sl_prev; \
    VRD(0); SBAR(); float sacc=(P0[0]+P0[1]); \
    GAPA(C0=__builtin_amdgcn_mfma_f32_32x32x16_bf16(kf[0],qr[0],negm,0,0,0), P0[2],P0[3],P0[4],P0[5],     pw0[0]=PKW(P0,0), pw0[1]=PKW(P0,2), pw0); \
    VRD(4); SBAR(); GAPA(C1=__builtin_amdgcn_mfma_f32_32x32x16_bf16(kf[1],qr[0],negm,0,0,0), P0[6],P0[7],P0[8],P0[9],     pw0[2]=PKW(P0,4), pw0[3]=PKW(P0,6), pw0); \
    VRD(1); SBAR(); GAPA(C0=__builtin_amdgcn_mfma_f32_32x32x16_bf16(kf[2],qr[1],C0,0,0,0),   P0[10],P0[11],P0[12],P0[13], pw1[0]=PKW(P0,8), pw1[1]=PKW(P0,10), pw1); \
    VRD(5); SBAR(); GAPA(C1=__builtin_amdgcn_mfma_f32_32x32x16_bf16(kf[3],qr[1],C1,0,0,0),   P0[14],P0[15],P1[0],P1[1],   pw1[2]=PKW(P0,12),pw1[3]=PKW(P0,14), pw1); \
    VRD(2); SBAR(); GAPA(C0=__builtin_amdgcn_mfma_f32_32x32x16_bf16(kf[4],qr[2],C0,0,0,0),   P1[2],P1[3],P1[4],P1[5],     pw2[0]=PKW(P1,0), pw2[1]=PKW(P1,2), pw2); \
    VRD(6); SBAR(); GAPA(C1=__builtin_amdgcn_mfma_f32_32x32x16_bf16(kf[5],qr[2],C1,0,0,0),   P1[6],P1[7],P1[8],P1[9],     pw2[2]=PKW(P1,4), pw2[3]=PKW(P1,6), pw2); \
    VRD(3); SBAR(); GAPA(C0=__builtin_amdgcn_mfma_f32_32x32x16_bf16(kf[6],qr[3],C0,0,0,0),   P1[10],P1[11],P1[12],P1[13], pw3[0]=PKW(P1,8), pw3[1]=PKW(P1,10), pw3); \
    VRD(7); SBAR(); GAPA(C1=__builtin_amdgcn_mfma_f32_32x32x16_bf16(kf[7],qr[3],C1,0,0,0),   P1[14],P1[15],0.f,0.f,       pw3[2]=PKW(P1,12),pw3[3]=PKW(P1,14), pw3); \
    l_reg+=sacc; \
    if(GK){DMA_K((t)+3,sl_cur);} if(GV){DMA_V((t)+1,sl_next);} \
    CMASK(C0,C1,t); \
    { float a=MX3(C0[0],C0[1],C1[0]),b=MX3(C0[2],C0[3],C1[1]); a=MX3(a,C1[2],C1[3]); \
      _Pragma("unroll") for(int r=4;r<16;r+=4){a=MX3(a,C0[r],C0[r+1]);b=MX3(b,C0[r+2],C0[r+3]);a=MX3(a,C1[r],C1[r+1]);b=MX3(b,C1[r+2],C1[r+3]);} \
      float rm=__builtin_fmaxf(a,b); { auto rr=__builtin_amdgcn_permlane32_swap(__float_as_uint(rm),__float_as_uint(rm),false,false); rm=__builtin_fmaxf(__uint_as_float(rr[0]),__uint_as_float(rr[1])); } \
      resc=false; \
      if(__builtin_expect(__any(rm>(float)THRL),0)){ const float dl=__builtin_fmaxf(rm,0.f); mhat+=dl; \
        _Pragma("unroll") for(int r=0;r<16;++r){C0[r]-=dl;C1[r]-=dl;} \
        _Pragma("unroll") for(int r=0;r<16;++r)negm[r]=-mhat; asm volatile("":"+v"(negm)); \
        const float f=__builtin_amdgcn_exp2f(-dl); l_reg*=f; if(hi==0)wsf[r32]=f; resc=true; } } \
    SBAR(); \
    GAPB(o[0]=__builtin_amdgcn_mfma_f32_32x32x16_bf16(PAF(0),VFR(0),o[0],0,0,0), C0,0); \
    GAPB(o[1]=__builtin_amdgcn_mfma_f32_32x32x16_bf16(PAF(0),VFR(4),o[1],0,0,0), C0,4); \
    KRD(GL,0); GAPB(o[0]=__builtin_amdgcn_mfma_f32_32x32x16_bf16(PAF(1),VFR(1),o[0],0,0,0), C0,8); \
    KRD(GL,1); GAPB(o[1]=__builtin_amdgcn_mfma_f32_32x32x16_bf16(PAF(1),VFR(5),o[1],0,0,0), C0,12); \
    KRD(GL,2); GAPB(o[0]=__builtin_amdgcn_mfma_f32_32x32x16_bf16(PAF(2),VFR(2),o[0],0,0,0), C1,0); \
    KRD(GL,3); GAPB(o[1]=__builtin_amdgcn_mfma_f32_32x32x16_bf16(PAF(2),VFR(6),o[1],0,0,0), C1,4); \
    GAPB(o[0]=__builtin_amdgcn_mfma_f32_32x32x16_bf16(PAF(3),VFR(3),o[0],0,0,0), C1,8); \
    GAPB(o[1]=__builtin_amdgcn_mfma_f32_32x32x16_bf16(PAF(3),VFR(7),o[1],0,0,0), C1,12); \
    }while(0)
  int t=1;
  #undef CMASK
  #define CMASK(P0,P1,t) do{}while(0)
  for(;t+5<NT;t+=2){
    STEP(pB0,pB1,pA0,pA1,t,true,true,true);     WAIT_BAR(2); RESC(); ROT();
    STEP(pA0,pA1,pB0,pB1,t+1,true,true,true);   WAIT_BAR(2); RESC(); ROT();
  }
  #undef CMASK
  #define CMASK(P0,P1,t) do{}while(0)
  #define ENDW(tt) do{ if((tt)+3<NT){WAIT_BAR(2);} else if((tt)+2<NT){WAIT_BAR(1);} else {WAIT_BAR(0);} }while(0)
  for(;t+1<NT;t+=2){
    STEP(pB0,pB1,pA0,pA1,t,(t+3<NT),(t+1<NT),(t+1<NT));       ENDW(t);   RESC(); ROT();
    STEP(pA0,pA1,pB0,pB1,t+1,(t+4<NT),(t+2<NT),(t+2<NT));     ENDW(t+1); RESC(); ROT();
  }
  STEP(pB0,pB1,pA0,pA1,NT-1,false,false,false); RESC();
  { float sacc=pB0[0]+pB0[1]; _Pragma("unroll") for(int r=2;r<16;++r)sacc+=pB0[r]; _Pragma("unroll") for(int r=0;r<16;++r)sacc+=pB1[r]; l_reg+=sacc;
    pw0=(u32x4){PKW(pB0,0),PKW(pB0,2),PKW(pB0,4),PKW(pB0,6)};pw1=(u32x4){PKW(pB0,8),PKW(pB0,10),PKW(pB0,12),PKW(pB0,14)};pw2=(u32x4){PKW(pB1,0),PKW(pB1,2),PKW(pB1,4),PKW(pB1,6)};pw3=(u32x4){PKW(pB1,8),PKW(pB1,10),PKW(pB1,12),PKW(pB1,14)};
    SBAR(); pv(o,vb0+sl_cur,PAF(0),PAF(1),PAF(2),PAF(3)); }
  #undef PKW
  #undef PAF
  #undef VFR
  #undef PIN
  #undef MX3
  #undef GAPA
  #undef GAPB
  #undef EX
  #undef VRD
  #undef KRD
  #undef STEP
  #undef ENDW
  {auto rr=__builtin_amdgcn_permlane32_swap(__float_as_uint(l_reg),__float_as_uint(l_reg),false,false);l_reg=__uint_as_float(rr[0])+__uint_as_float(rr[1]);}
  if(hi==0)wsf[32+r32]=l_reg;asm volatile("s_waitcnt lgkmcnt(0)":::"memory");
  float rli[16];
  #pragma unroll
  for(int r=0;r<16;++r)rli[r]=__builtin_amdgcn_rcpf(wsf[32+crow(r,hi)]);
  bf16*Ow=O+(rowbase+q0+wid*QBLK)*OPT+OCOL+h*D;
  { bf16*stg=(bf16*)(shm+LDS_OST)+wid*2048;
    #pragma unroll
    for(int r=0;r<16;++r){const int orow=crow(r,hi);
      #pragma unroll
      for(int d0=0;d0<2;++d0)stg[orow*64+d0*32+r32]=__float2bfloat16(o[d0][r]*rli[r]);}
    asm volatile("s_waitcnt lgkmcnt(0)":::"memory");
    #pragma unroll
    for(int i=0;i<4;++i){const int row=i*8+(lane>>3),ch=lane&7; const u32x4 v=*(const u32x4*)(stg+row*64+ch*8); ATTN_STORE16(Ow+(long)row*OPT+ch*8,v);} }
  asm volatile("s_waitcnt lgkmcnt(0)\n\ts_barrier":::"memory");
  #undef DMA_K
  #undef DMA_V
  #undef CMASK
  #undef START
  #undef RESC
  #undef ROT
}
constexpr int ATTN_LDS_BYTES=LDS_BYTES;
#undef SBAR
#undef WAIT_BAR
}
#define GAS __attribute__((address_space(1)))
#define LAS __attribute__((address_space(3)))
typedef unsigned short bf16;
typedef unsigned v4u __attribute__((ext_vector_type(4)));
typedef float f32x4 __attribute__((ext_vector_type(4)));
typedef float f32x16 __attribute__((ext_vector_type(16)));
typedef short bf16x8 __attribute__((ext_vector_type(8)));
typedef unsigned u32x2 __attribute__((ext_vector_type(2)));
#define LDS_WAIT() asm volatile("s_waitcnt lgkmcnt(0)" ::: "memory")
__device__ __forceinline__ unsigned f2bf(float f) { unsigned u = __builtin_bit_cast(unsigned, f); return (u + 0x7fffu + ((u >> 16) & 1u)) >> 16; }
__device__ __forceinline__ unsigned pk2(float lo, float hi) { return f2bf(lo) | (f2bf(hi) << 16); }
__device__ __forceinline__ float wave_sum(float v) {
#pragma unroll
    for (int o = 1; o < 64; o <<= 1) v += __shfl_xor(v, o);
    return v;
}
constexpr int NWAVES = 8;
constexpr int LDS_BYTES = 147456;
constexpr size_t MiB = 1u << 20;
constexpr size_t WS_TAB = 1 * MiB;
constexpr size_t TAB_COSA = WS_TAB, TAB_SINA = WS_TAB + 8192, TAB_COSB = WS_TAB + 16384, TAB_SINB = WS_TAB + 16384 + 262144, TAB_QKN = WS_TAB + 16384 + 2 * 262144;
constexpr size_t WS_PART = 2 * MiB;
constexpr size_t WS_W13_1 = 8 * MiB, WS_W13_2 = 19 * MiB, WS_W2_1 = 30 * MiB, WS_W2_2 = 36 * MiB, WS_WIN = 42 * MiB, WS_WBA = 52 * MiB, WS_WBB = 53 * MiB, WS_WO = 54 * MiB;
constexpr size_t WS_XB = 60 * MiB;
constexpr size_t WS_R = 220 * MiB;
constexpr size_t R_QA = WS_R, R_KA = WS_R + 80 * MiB, R_VA = WS_R + 100 * MiB, R_QB = WS_R + 120 * MiB, R_KB = WS_R + 240 * MiB, R_VB = WS_R + 360 * MiB, R_GA = WS_R + 480 * MiB, R_GB = WS_R + 640 * MiB;
constexpr size_t R_TMP = WS_R + 120 * MiB, R_MG = WS_R + 280 * MiB;
constexpr size_t WS_END = 1020 * MiB;

__device__ __forceinline__ int rowmap(int mode, int n) {
    if (mode == 0) return n;
    if (mode == 1) { const int b = n >= DFF ? 1 : 0, j = n - b * DFF; return (j >> 7) * 256 + b * 128 + (j & 127); }
    const int pn = n >> 8, hl = (n >> 6) & 3; int dd = n & 63;
    if (pn >= 3 && pn < 9) { if (dd >= 8 && dd < 16) dd += 8; else if (dd >= 16 && dd < 24) dd -= 8; }
    const bool rope = (pn < 2) || (pn == 2 && hl < 2) || (pn >= 3 && pn < 9);
    const int dl = dd & 31;
    const int pos32 = rope ? dl : (16 * ((dl >> 2) & 1) + 4 * (dl >> 3) + (dl & 3));
    return pn * 256 + (dd >> 5) * 128 + hl * 32 + pos32;
}
__device__ __forceinline__ void p0_transpose_item(const float* W, const float* gain, int K, int N, bf16* WT, int mode, LAS float* scr, int item, int lane, int kpitch = 0, int koff = 0) {
    if (kpitch == 0) kpitch = K;
    const int nblk = N / 32, kb = item / nblk, nb = item % nblk, k0 = 64 * kb, n0 = 32 * nb;
#pragma unroll 8
    for (int i = 0; i < 32; ++i) { const int kk = 2 * i + (lane >> 5); const float gsc = gain ? gain[k0 + kk] : 1.0f; scr[kk * 33 + (lane & 31)] = W[(size_t)(k0 + kk) * N + n0 + (lane & 31)] * gsc; }
    LDS_WAIT(); asm volatile("" ::: "memory");
    const int c = lane & 7;
#pragma unroll
    for (int j = 0; j < 4; ++j) { const int n = (lane >> 3) + 8 * j; const LAS float* s = scr + (8 * c) * 33 + n;
        v4u o; o.x = pk2(s[0 * 33], s[1 * 33]); o.y = pk2(s[2 * 33], s[3 * 33]); o.z = pk2(s[4 * 33], s[5 * 33]); o.w = pk2(s[6 * 33], s[7 * 33]);
        *(GAS v4u*)(WT + (size_t)rowmap(mode, n0 + n) * kpitch + koff + k0 + 8 * c) = o; }
    LDS_WAIT(); asm volatile("" ::: "memory");
}

namespace dil {
constexpr int OPB = 144;
constexpr int L_O = 0, L_M = 512 * OPB, L_L = L_M + 2048, L_V = L_L + 2048;
static_assert(L_V + 8 * 4096 <= 147456, "dil LDS map");
typedef short v4i16_t __attribute__((ext_vector_type(4)));
__device__ __forceinline__ int crow(int r, int hi) { return (r & 3) + 8 * (r >> 2) + 4 * hi; }
__device__ __forceinline__ unsigned cvtpk(float lo, float hi) { unsigned r; asm volatile("v_cvt_pk_bf16_f32 %0, %1, %2" : "=v"(r) : "v"(lo), "v"(hi)); return r; }
__device__ __forceinline__ v4i16_t vtr(const LAS unsigned char* p) { return __builtin_amdgcn_ds_read_tr16_b64_v4i16((LAS v4i16_t*)p); }
__device__ __forceinline__ float bflo(unsigned w) { return __uint_as_float(w << 16); }
__device__ __forceinline__ float bfhi(unsigned w) { return __uint_as_float(w & 0xffff0000u); }
__device__ __forceinline__ void unit(int u, const bf16* QB, const bf16* KB, const bf16* VB, bf16* OB, LAS unsigned char* lds) {
    const int tid = opaque_tid(), lane = tid & 63, wid = __builtin_amdgcn_readfirstlane(tid >> 6);
    const int blk = u >> 2, hs = u & 3, row0 = blk * 512;
    int S, seq0;
    if (row0 < T_PROMPT) { S = 4096; seq0 = row0 & ~4095; } else { S = 8192; seq0 = row0 & ~8191; }
    const int tb = row0 - seq0;
    LAS float* Ml = (LAS float*)(lds + L_M); LAS float* Ll = (LAS float*)(lds + L_L);
    LAS unsigned char* vst = lds + L_V + wid * 4096;
    const LAS unsigned char* vtrb = vst + ((lane >> 4) & 1) * 32 + (lane & 3) * 8 + (4 * (lane >> 5) + ((lane & 15) >> 2)) * 64;
    const int c32 = lane & 31, hi = lane >> 5;
#pragma unroll 1
    for (int g = 0; g < 3; ++g) {
        const int sh = 2 * g, nsub = 16 >> sh, Ld = S >> sh, h = g * 4 + hs;
#pragma unroll 1
        for (int jj = 0; jj < 2; ++jj) {
            const int j = 2 * wid + jj, r = j >> (4 - sh), sb = j & (nsub - 1);
            const int iq0 = (tb >> sh) + 32 * sb;
            const int tokl = r + ((32 * sb + c32) << sh);
            const size_t hb = ((size_t)h * T_ROWS + seq0 + (size_t)r * Ld) * 64;
            const bf16* qp = QB + hb + (size_t)(iq0 + c32) * 64 + hi * 8;
            bf16x8 qf[4], kf[5][4];
#pragma unroll
            for (int d0 = 0; d0 < 4; ++d0) qf[d0] = *(const bf16x8*)(qp + d0 * 16);
#pragma unroll
            for (int kb = 0; kb < 5; ++kb) {
                int ik = iq0 - 64 + 32 * kb + c32; ik = ik < 0 ? 0 : (ik > Ld - 1 ? Ld - 1 : ik);
                const bf16* kp = KB + hb + (size_t)ik * 64 + hi * 8;
#pragma unroll
                for (int d0 = 0; d0 < 4; ++d0) kf[kb][d0] = *(const bf16x8*)(kp + d0 * 16);
            }
            v4u vr[3][4];
#define DIL_VLOAD(kb_) do { _Pragma("unroll") for (int kg = 0; kg < 2; ++kg) { int kk = iq0 - 64 + 32 * (kb_) + 16 * kg + (lane >> 2); kk = kk < 0 ? 0 : (kk > Ld - 1 ? Ld - 1 : kk); \
                const bf16* vp = VB + hb + (size_t)kk * 64 + (lane & 3) * 8; \
                vr[(kb_) % 3][kg] = *(const v4u*)vp; vr[(kb_) % 3][2 + kg] = *(const v4u*)(vp + 32); } } while (0)
            f32x16 s[5];
            const bool interior = (iq0 >= 64) && (iq0 + 96 <= Ld);
#pragma unroll
            for (int kb = 0; kb < 5; ++kb) {
                f32x16 acc = {};
#pragma unroll
                for (int d0 = 0; d0 < 4; ++d0) acc = __builtin_amdgcn_mfma_f32_32x32x16_bf16(kf[kb][d0], qf[d0], acc, 0, 0, 0);
                if (interior) {
                    if (kb == 0) {
#pragma unroll
                        for (int rr = 0; rr < 16; ++rr) s[kb][rr] = (crow(rr, hi) >= c32) ? acc[rr] : -1e30f;
                    } else if (kb == 4) {
#pragma unroll
                        for (int rr = 0; rr < 16; ++rr) s[kb][rr] = (crow(rr, hi) <= c32) ? acc[rr] : -1e30f;
                    } else s[kb] = acc;
                } else {
#pragma unroll
                for (int rr = 0; rr < 16; ++rr) { const int kk = iq0 - 64 + 32 * kb + crow(rr, hi); const int dq = 32 * kb - 64 + crow(rr, hi) - c32;
                    const bool valid = (dq >= -64) && (dq <= 64) && (kk >= 0) && (kk < Ld); s[kb][rr] = valid ? acc[rr] : -1e30f; }
                }
            }
            DIL_VLOAD(0); DIL_VLOAD(1); DIL_VLOAD(2);
            float mx = -1e30f;
#pragma unroll
            for (int kb = 0; kb < 5; ++kb)
#pragma unroll
                for (int rr = 0; rr < 16; ++rr) mx = fmaxf(mx, s[kb][rr]);
            mx = xmax32(mx);
            float l = 0.f;
#pragma unroll
            for (int kb = 0; kb < 5; ++kb)
#pragma unroll
                for (int rr = 0; rr < 16; ++rr) { const float p = __builtin_amdgcn_exp2f(s[kb][rr] - mx); s[kb][rr] = p; l += p; }
            l = xsum32(l);
            f32x16 o[2]; o[0] = f32x16{}; o[1] = f32x16{};
#pragma unroll
            for (int kb = 0; kb < 5; ++kb) {
#pragma unroll
                for (int bl = 0; bl < 4; ++bl) *(LAS v4u*)(vst + bl * 1024 + lane * 16) = vr[kb % 3][bl];
                if (kb + 3 < 5) { DIL_VLOAD(kb + 3); }
#pragma unroll
                for (int ks = 0; ks < 2; ++ks) {
                    v4u pw; pw.x = cvtpk(s[kb][8 * ks + 0], s[kb][8 * ks + 1]); pw.y = cvtpk(s[kb][8 * ks + 2], s[kb][8 * ks + 3]); pw.z = cvtpk(s[kb][8 * ks + 4], s[kb][8 * ks + 5]); pw.w = cvtpk(s[kb][8 * ks + 6], s[kb][8 * ks + 7]);
                    const bf16x8 pf = __builtin_bit_cast(bf16x8, pw);
#pragma unroll
                    for (int db = 0; db < 2; ++db) {
                        const v4i16_t lo = vtr(vtrb + (db * 2 + ks) * 1024), hh = vtr(vtrb + (db * 2 + ks) * 1024 + 512);
                        const bf16x8 vf = (bf16x8){lo[0], lo[1], lo[2], lo[3], hh[0], hh[1], hh[2], hh[3]};
                        o[db] = __builtin_amdgcn_mfma_f32_32x32x16_bf16(vf, pf, o[db], 0, 0, 0);
                    }
                }
            }
#undef DIL_VLOAD
            LAS unsigned char* ob = lds + L_O + tokl * OPB + 8 * hi;
            if (g > 0) {
                const float mp = Ml[tokl], lp = Ll[tokl];
                const float mn = fmaxf(mp, mx), a = __builtin_amdgcn_exp2f(mp - mn), b = __builtin_amdgcn_exp2f(mx - mn);
#pragma unroll
                for (int blk2 = 0; blk2 < 2; ++blk2)
#pragma unroll
                    for (int k = 0; k < 4; ++k) { const u32x2 pv = *(const LAS u32x2*)(ob + 64 * blk2 + 16 * k);
                        o[blk2][4 * k + 0] = a * bflo(pv.x) + b * o[blk2][4 * k + 0]; o[blk2][4 * k + 1] = a * bfhi(pv.x) + b * o[blk2][4 * k + 1];
                        o[blk2][4 * k + 2] = a * bflo(pv.y) + b * o[blk2][4 * k + 2]; o[blk2][4 * k + 3] = a * bfhi(pv.y) + b * o[blk2][4 * k + 3]; }
                l = a * lp + b * l; mx = mn;
            }
            if (g < 2) {
#pragma unroll
                for (int blk2 = 0; blk2 < 2; ++blk2)
#pragma unroll
                    for (int k = 0; k < 4; ++k) { u32x2 w; w.x = cvtpk(o[blk2][4 * k], o[blk2][4 * k + 1]); w.y = cvtpk(o[blk2][4 * k + 2], o[blk2][4 * k + 3]); *(LAS u32x2*)(ob + 64 * blk2 + 16 * k) = w; }
                if (hi == 0) { Ml[tokl] = mx; Ll[tokl] = l; }
            } else {
                const float il = 1.0f / l;
                bf16* dp = OB + (size_t)(row0 + tokl) * 768 + hs * 64 + 4 * hi;
#pragma unroll
                for (int blk2 = 0; blk2 < 2; ++blk2)
#pragma unroll
                    for (int k = 0; k < 4; ++k) { u32x2 w; w.x = cvtpk(o[blk2][4 * k] * il, o[blk2][4 * k + 1] * il); w.y = cvtpk(o[blk2][4 * k + 2] * il, o[blk2][4 * k + 3] * il);
                        *(u32x2*)(dp + 32 * blk2 + 8 * k) = w; }
            }
        }
        __syncthreads();
    }
}
}

#define XB_TMO      128
#define XB_XCNT(j)  (256  + 64 * (j))
#define XB_XSUB(j)  (1280 + 64 * (j))
#define XB_XGEN(j)  (2304 + 64 * (j))
#define XB_TOP      3328
#define XB_TOPGEN   3392
#define XCD_BAR_WORDS 3456
#define XB_SPIN_CAP (1u << 18)

__device__ __forceinline__ unsigned xb_ld(unsigned* p)              { return __hip_atomic_load(p, __ATOMIC_RELAXED, __HIP_MEMORY_SCOPE_AGENT); }
__device__ __forceinline__ unsigned xb_add(unsigned* p, unsigned v) { return __hip_atomic_fetch_add(p, v, __ATOMIC_RELAXED, __HIP_MEMORY_SCOPE_AGENT); }
__device__ __forceinline__ unsigned xb_xcc_id() { return (unsigned)__builtin_amdgcn_s_getreg((3 << 11) | 20) & 0xFu; }
#define XB_SPIN(cond, bar) do { unsigned _sp = 0; while (cond) { __builtin_amdgcn_s_sleep(1); \
    if ((++_sp & 255u) == 0u) { if (xb_ld(&(bar)[XB_TMO])) break; if (_sp > XB_SPIN_CAP) { atomicAdd(&(bar)[XB_TMO], 1u); break; } } } } while (0)

struct XcdBarrier {
    unsigned* bar; unsigned x;
    volatile LAS unsigned* st;
};

__device__ __forceinline__ XcdBarrier xcd_barrier_post(unsigned* bar, volatile LAS unsigned* st) {
    XcdBarrier b; b.bar = bar; b.x = xb_xcc_id(); b.st = st;
    if (threadIdx.x == 0) (void)xb_add(&bar[XB_XCNT(b.x)], 1u);
    return b;
}
__device__ __forceinline__ void xcd_barrier_complete(unsigned* bar, unsigned x, unsigned& nloc, unsigned& nx) {
    const unsigned G = gridDim.x * gridDim.y * gridDim.z;
    unsigned sum, cnt, mine, sp = 0u;
    for (;;) {
        sum = 0u; cnt = 0u; mine = 0u;
#pragma unroll
        for (unsigned j = 0; j < 16; ++j) { const unsigned c = xb_ld(&bar[XB_XCNT(j)]); sum += c; cnt += (c > 0u) ? 1u : 0u; mine = (j == x) ? c : mine; }
        if (sum == G) break;
        __builtin_amdgcn_s_sleep(1);
        if ((++sp & 255u) == 0u) { if (xb_ld(&bar[XB_TMO])) break; if (sp > XB_SPIN_CAP) { atomicAdd(&bar[XB_TMO], 1u); break; } }
    }
    nloc = mine > 0u ? mine : 1u; nx = cnt > 0u ? cnt : 1u;
}

__device__ __forceinline__ void xcd_barrier(const XcdBarrier& b) {
    asm volatile("s_waitcnt vmcnt(0)" ::: "memory");
    __syncthreads();
    if (threadIdx.x == 0) {
        unsigned* bar = b.bar;
        __builtin_amdgcn_s_waitcnt(0);
        unsigned nloc = b.st[0], nx = b.st[1];
        if (nloc == 0u) { xcd_barrier_complete(bar, b.x, nloc, nx); b.st[0] = nloc; b.st[1] = nx; }
        const unsigned old = xb_add(&bar[XB_XSUB(b.x)], 1u);
        const unsigned gen = old / nloc;
        if (old + 1u == (gen + 1u) * nloc) {
            __builtin_amdgcn_fence(__ATOMIC_RELEASE, "agent");
            asm volatile("s_waitcnt vmcnt(0)" ::: "memory");
            const unsigned og = xb_add(&bar[XB_TOP], 1u);
            const unsigned tg = og / nx;
            if (og + 1u == (tg + 1u) * nx) xb_add(&bar[XB_TOPGEN], 1u);
            else XB_SPIN(xb_ld(&bar[XB_TOPGEN]) == tg, bar);
            __builtin_amdgcn_fence(__ATOMIC_ACQUIRE, "agent");
            xb_add(&bar[XB_XGEN(b.x)], 1u);
            asm volatile("s_waitcnt vmcnt(0)" ::: "memory");
        } else {
            XB_SPIN(xb_ld(&bar[XB_XGEN(b.x)]) == gen, bar);
            __builtin_amdgcn_fence(__ATOMIC_ACQUIRE, "agent");
            asm volatile("s_waitcnt vmcnt(0)" ::: "memory");
        }
    }
    __syncthreads();
}

constexpr size_t WS_BAR = 65536 * 4;
constexpr int MISC_OFF = 131072 + 320;
struct Args { const float* in[16]; float* out; unsigned char* ws; };

__global__ void __launch_bounds__(NWAVES * 64, 2) fwd_mega(Args args) {
    extern __shared__ __attribute__((aligned(16))) unsigned char lds[];
    cg::grid_group grid = cg::this_grid();
    LAS unsigned char* l3 = (LAS unsigned char*)lds;
    volatile LAS unsigned* bst = (volatile LAS unsigned*)(l3 + MISC_OFF);
    if (threadIdx.x < 2) bst[threadIdx.x] = 0u;
    const int G = gridDim.x, bx = blockIdx.x;
    const int vcu = (G % 8 == 0) ? (bx % 8) * (G / 8) + bx / 8 : bx;
    unsigned char* ws = args.ws;
    const float* xp = args.in[0]; const float* xs = args.in[1];
    float* out = args.out;
    float* part = (float*)(ws + WS_PART);
    bf16 *W13_1 = (bf16*)(ws + WS_W13_1), *W13_2 = (bf16*)(ws + WS_W13_2), *W2_1 = (bf16*)(ws + WS_W2_1), *W2_2 = (bf16*)(ws + WS_W2_2), *WIN = (bf16*)(ws + WS_WIN), *WBA = (bf16*)(ws + WS_WBA), *WBB = (bf16*)(ws + WS_WBB), *WO = (bf16*)(ws + WS_WO);
    bf16 *XB = (bf16*)(ws + WS_XB), *OCAT = (bf16*)out, *GH = (bf16*)(ws + WS_R);
    bf16 *QA = (bf16*)(ws + R_QA), *KA = (bf16*)(ws + R_KA), *VA = (bf16*)(ws + R_VA), *QBm = (bf16*)(ws + R_QB), *KBm = (bf16*)(ws + R_KB), *VBm = (bf16*)(ws + R_VB), *GA = (bf16*)(ws + R_GA), *GB = (bf16*)(ws + R_GB);
    bf16 *TMP = (bf16*)(ws + R_TMP), *MG = (bf16*)(ws + R_MG);
    float *cosA = (float*)(ws + TAB_COSA), *sinA = (float*)(ws + TAB_SINA), *cosB = (float*)(ws + TAB_COSB), *sinB = (float*)(ws + TAB_SINB), *qkn = (float*)(ws + TAB_QKN);
    const int NGW = G * NWAVES;

    {
        const int tid = opaque_tid(), lane = tid & 63, wave = __builtin_amdgcn_readfirstlane(tid >> 6), gw = vcu * NWAVES + wave;
        LAS float* scr = (LAS float*)(l3 + wave * 16384);
        constexpr int I13 = (1024 / 64) * (5632 / 32), I2 = (2816 / 64) * (1024 / 32), IIN = (1024 / 64) * (5120 / 32), IBA = (512 / 64) * (1024 / 32), IBB = (256 / 64) * (1024 / 32), IO = (1024 / 64) * (1024 / 32);
        constexpr int NITEMS = 2 * I13 + 2 * I2 + IIN + IBA + IBB + IO;
        for (int it = gw; it < NITEMS; it += NGW) {
            int r = it;
            if (r < I13) { p0_transpose_item(args.in[3], args.in[2], 1024, 5632, W13_1, 1, scr, r, lane); continue; } r -= I13;
            if (r < I13) { p0_transpose_item(args.in[13], args.in[12], 1024, 5632, W13_2, 1, scr, r, lane); continue; } r -= I13;
            if (r < I2) { p0_transpose_item(args.in[4], nullptr, 2816, 1024, W2_1, 0, scr, r, lane); continue; } r -= I2;
            if (r < I2) { p0_transpose_item(args.in[14], nullptr, 2816, 1024, W2_2, 0, scr, r, lane); continue; } r -= I2;
            if (r < IIN) { p0_transpose_item(args.in[6], args.in[5], 1024, 5120, WIN, 2, scr, r, lane); continue; } r -= IIN;
            if (r < IBA) { p0_transpose_item(args.in[9], nullptr, 512, 1024, WBA, 0, scr, r, lane, 768, 256); continue; } r -= IBA;
            if (r < IBB) { p0_transpose_item(args.in[10], nullptr, 256, 1024, WBA, 0, scr, r, lane, 768, 0); continue; } r -= IBB;
            p0_transpose_item(args.in[11], nullptr, 1024, 1024, WO, 0, scr, r, lane);
        }
        const int gt = vcu * 512 + tid, NGT = G * 512;
        if (gt < 128) qkn[gt] = gt < 64 ? args.in[7][gt] : args.in[8][gt - 64];
        if (bx == 0) for (int e = tid; e < XCD_BAR_WORDS; e += 512) ((unsigned*)(ws + WS_BAR))[e] = 0u;
        for (int e = gt; e < 128 * 16 + 8192 * 8; e += NGT) {
            if (e < 128 * 16) { const int pos = e >> 4, i = e & 15; const float inv = exp2f(-(float)(2 * i) / 32.0f * 13.287712379549449f); const float ang = (float)pos * inv; float sn, cs; sincosf(ang, &sn, &cs); cosA[e] = cs; sinA[e] = sn; }
            else { const int e2 = e - 128 * 16, pos = e2 >> 3, i = e2 & 7; const float inv = exp2f(-(float)(2 * i) / 16.0f * 18.931568569324174f); const float ang = (float)pos * inv; float sn, cs; sincosf(ang, &sn, &cs); cosB[e2] = cs; sinB[e2] = sn; }
        }
        for (int m = gw; m < T_ROWS; m += NGW) {
            const float* xr = (m < T_PROMPT) ? xp + (size_t)m * DMODEL : xs + (size_t)(m - T_PROMPT) * DMODEL;
            const GAS f32x4* x4 = (const GAS f32x4*)xr + lane;
            f32x4 v[4]; float s = 0.f;
#pragma unroll
            for (int j = 0; j < 4; ++j) { v[j] = __builtin_nontemporal_load(x4 + 64 * j); s += (v[j].x * v[j].x + v[j].y * v[j].y) + (v[j].z * v[j].z + v[j].w * v[j].w); }
            s = wave_sum(s);
            GAS unsigned long long* o8 = (GAS unsigned long long*)(XB + (size_t)m * DMODEL) + lane;
#pragma unroll
            for (int j = 0; j < 4; ++j) o8[64 * j] = (unsigned long long)pk2(v[j].x, v[j].y) | ((unsigned long long)pk2(v[j].z, v[j].w) << 32);
            if (lane < 16) part[(size_t)m * 16 + lane] = lane == 0 ? s : 0.f;
        }
    }
    grid.sync();
    const XcdBarrier xbar = xcd_barrier_post((unsigned*)(ws + WS_BAR), bst);
    { pg8::Gemm g{XB, W13_1, T_ROWS, 2 * DFF, DMODEL}; pg8::StaticOrder S; S.init(T_ROWS, 2 * DFF, G, bx); pg8::EpiSwiglu E{GH, part};
      pg8::gemm_phase<pg8::EpiSwiglu, pg8::StaticOrder, true, true>(l3, g, S, E); }
    xcd_barrier(xbar);
    { pg8::Gemm g{GH, W2_1, T_ROWS, DMODEL, DFF}; pg8::StaticOrder S; S.init(T_ROWS, DMODEL, G, bx); pg8::EpiResid<false> E{xp, xs, nullptr, nullptr, XB, part, 0.5f, 2.0f};
      pg8::gemm_phase<pg8::EpiResid<false>, pg8::StaticOrder, true, true, true>(l3, g, S, E); }
    xcd_barrier(xbar);
#ifndef NO_P3
    { pg8::Gemm g{XB, WIN, T_ROWS, INW, DMODEL}; pg8::StaticOrder S; S.init(T_ROWS, INW, G, bx);
      pg8::EpiProj E{QA, KA, VA, QBm, KBm, VBm, GA, GB, cosA, sinA, cosB, sinB, qkn, part};
      pg8::gemm_phase<pg8::EpiProj, pg8::StaticOrder, true, true>(l3, g, S, E); }
    xcd_barrier(xbar);
#endif
    {
#ifndef NO_ATTA
        for (int i = vcu; i < 2560; i += G) {
            long rowbase; int S, h, q0;
            if (i < 2048) { const int seq = i >> 7, rem = i & 127; h = (rem >> 4); q0 = (rem & 15) * 256; rowbase = (long)seq * 4096; S = 4096; }
            else { const int i2 = i - 2048, seq = i2 >> 8, rem = i2 & 255; h = (rem >> 5); q0 = (rem & 31) * 256; rowbase = (long)T_PROMPT + (long)seq * 8192; S = 8192; }
            attn_body::attn_unit<8>(rowbase, S, h, q0, (const attn_body::bf16*)QA, (const attn_body::bf16*)KA, (const attn_body::bf16*)VA, (attn_body::bf16*)OCAT, (char*)lds);
        }
#endif
        __syncthreads();
#ifndef NO_ATTB
        for (int u = vcu; u < 640; u += G) dil::unit(u, QBm, KBm, VBm, OCAT, l3);
#endif
    }
    xcd_barrier(xbar);
    { pg8::Gemm g{OCAT, WBA, T_ROWS, DMODEL, 768}; pg8::StaticOrder S; S.init(T_ROWS, DMODEL, G, bx); pg8::EpiGate2 E{GA, GB, MG};
      pg8::gemm_phase<pg8::EpiGate2, pg8::StaticOrder, true, true>(l3, g, S, E); }
    xcd_barrier(xbar);
    { pg8::Gemm g{MG, WO, T_ROWS, DMODEL, DMODEL}; pg8::StaticOrder S; S.init(T_ROWS, DMODEL, G, bx); pg8::EpiResid<true> E{nullptr, nullptr, XB, nullptr, XB, part, 1.0f, 1.0f};
      pg8::gemm_phase<pg8::EpiResid<true>, pg8::StaticOrder, true, true>(l3, g, S, E); }
    xcd_barrier(xbar);
    { pg8::Gemm g{XB, W13_2, T_ROWS, 2 * DFF, DMODEL}; pg8::StaticOrder S; S.init(T_ROWS, 2 * DFF, G, bx); pg8::EpiSwiglu E{GH, part};
      pg8::gemm_phase<pg8::EpiSwiglu, pg8::StaticOrder, true, true>(l3, g, S, E); }
    xcd_barrier(xbar);
    { pg8::Gemm g{GH, W2_2, T_ROWS, DMODEL, DFF}; pg8::StaticOrder S; S.init(T_ROWS, DMODEL, G, bx); pg8::EpiResid<true> E{nullptr, nullptr, XB, out, nullptr, part, 0.5f, 2.0f};
      pg8::gemm_phase<pg8::EpiResid<true>, pg8::StaticOrder, true, true, true>(l3, g, S, E); }
    xcd_barrier(xbar);
    {
        const int tid = opaque_tid(), lane = tid & 63, wave = __builtin_amdgcn_readfirstlane(tid >> 6), gw = vcu * NWAVES + wave;
        const float* gf = args.in[15];
        f32x4 gv[4];
#pragma unroll
        for (int j = 0; j < 4; ++j) gv[j] = *((const f32x4*)gf + lane + 64 * j);
        for (int m = gw; m < T_ROWS; m += NGW) {
            float s = lane < 16 ? part[(size_t)m * 16 + lane] : 0.f;
            s = wave_sum(s);
            const float rs = rsqrtf(s * (1.0f / 1024.0f) + RMS_EPS);
            GAS f32x4* o4 = (GAS f32x4*)(out + (size_t)m * DMODEL) + lane;
#pragma unroll
            for (int j = 0; j < 4; ++j) { f32x4 v = o4[64 * j]; v = v * rs * gv[j]; __builtin_nontemporal_store(v, o4 + 64 * j); }
        }
    }
}

extern "C" void kernel_launch(void* const* d_in, const int* in_sizes, int n_in, void* d_out, int out_size, void* d_ws, size_t ws_size, hipStream_t stream) {
    static int grid = 0;
    if (grid == 0) {
        if (n_in != 16 || out_size != T_ROWS * DMODEL || ws_size < WS_END) { fprintf(stderr, "kernel_launch: unexpected problem (n_in %d out %d ws %zu); nothing launched\n", n_in, out_size, ws_size); grid = -1; return; }
        int dev = 0, cus = 0, per_cu = 0;
        if (hipGetDevice(&dev) != hipSuccess || hipDeviceGetAttribute(&cus, hipDeviceAttributeMultiprocessorCount, dev) != hipSuccess) { grid = -1; return; }
        if (hipFuncSetAttribute((const void*)fwd_mega, hipFuncAttributeMaxDynamicSharedMemorySize, LDS_BYTES) != hipSuccess) { fprintf(stderr, "kernel_launch: hipFuncSetAttribute failed\n"); grid = -1; return; }
        if (hipOccupancyMaxActiveBlocksPerMultiprocessor(&per_cu, (const void*)fwd_mega, NWAVES * 64, LDS_BYTES) != hipSuccess || per_cu < 1) { fprintf(stderr, "kernel_launch: occupancy query says %d\n", per_cu); per_cu = 1; }
        (void)hipGetLastError();
        grid = cus;
    }
    if (grid < 0) return;
    Args a{};
    for (int i = 0; i < 16; ++i) a.in[i] = (const float*)d_in[i];
    a.out = (float*)d_out; a.ws = (unsigned char*)d_ws;
    void* kargs[] = {&a};
    hipError_t e = hipLaunchCooperativeKernel((const void*)fwd_mega, dim3(grid), dim3(NWAVES * 64), kargs, LDS_BYTES, stream);
    if (e != hipSuccess) fprintf(stderr, "cooperative launch failed: %s (grid %d)\n", hipGetErrorString(e), grid);
}
```

```cpp
#include <hip/hip_runtime.h>
#include <hip/hip_cooperative_groups.h>
#include <cstdio>
#include <cstdint>
namespace cg = cooperative_groups;
constexpr int T_ROWS = 81920, T_PROMPT = 65536, DMODEL = 1024, DFF = 2816, INW = 5120;
constexpr float RMS_EPS = 1e-6f;
constexpr float QK_C2 = 0.125f * 1.4426950408889634f;
__device__ __forceinline__ int opaque_tid() { int t = threadIdx.x; asm volatile("" : "+v"(t)); return t; }
__device__ __forceinline__ float xsum16(float v) { const auto r = __builtin_amdgcn_permlane16_swap(__float_as_uint(v), __float_as_uint(v), false, false); return __uint_as_float(r[0]) + __uint_as_float(r[1]); }
__device__ __forceinline__ float xsum32(float v) { const auto r = __builtin_amdgcn_permlane32_swap(__float_as_uint(v), __float_as_uint(v), false, false); return __uint_as_float(r[0]) + __uint_as_float(r[1]); }
__device__ __forceinline__ float xmax32(float v) { const auto r = __builtin_amdgcn_permlane32_swap(__float_as_uint(v), __float_as_uint(v), false, false); return fmaxf(__uint_as_float(r[0]), __uint_as_float(r[1])); }
namespace pg8 {
#define PG8_LAS __attribute__((address_space(3)))
typedef unsigned short bf16_t;
typedef short bf16x8 __attribute__((ext_vector_type(8)));
typedef float f32x4 __attribute__((ext_vector_type(4)));
typedef unsigned u32x4 __attribute__((ext_vector_type(4)));
constexpr int BM = 256, BK = 64, HALF = 128, HTB = HALF * BK * 2  , STAGE_BYTES = 8 * HTB, NXCD = 8, WGM = 8;

__host__ __device__ __forceinline__ int lds_byte(int r, int c) { const int st = (r >> 4) * 2 + (c >> 5), rr = r & 15, cc = c & 31, ob = rr * 64 + cc * 2; return st * 1024 + (ob ^ (((ob >> 9) & 1) << 5)); }
__host__ __device__ __forceinline__ void stage_rc(int b, int& R, int& C) { const int st = b / 1024, sb = b % 1024, swz = sb ^ (((sb >> 9) & 1) << 5); R = (st >> 1) * 16 + swz / 64; C = (st & 1) * 32 + (swz % 64) / 2; }
__host__ __device__ __forceinline__ int perm32(int rho) { const int n = rho >> 4, i = rho & 15; return 8 * (i >> 2) + 4 * n + (i & 3); }

struct Unit { int pm, pn; };
struct Gemm { const bf16_t* A; const bf16_t* Bt; int M, N, K; };

struct StaticOrder {
    int nM, nN, nwg, G, c;
    __host__ __device__ void init(int M, int N, int G_, int c_) { nM = M / BM; nN = N / BM; nwg = nM * nN; G = G_; c = c_; }
    __host__ __device__ bool next(int i, Unit& u) const {
        const long L = (long)i * G + c; if (L >= nwg) return false;
        int wgid = (int)L; { const int q = nwg / NXCD, r = nwg % NXCD, xcd = wgid % NXCD, off = wgid / NXCD; wgid = (xcd < r ? xcd * (q + 1) : r * (q + 1) + (xcd - r) * q) + off; }
        const int nig = WGM * nN, gid = wgid / nig, fm = gid * WGM, gsz = (nM - fm) < WGM ? (nM - fm) : WGM;
        u.pm = fm + ((wgid % nig) % gsz); u.pn = (wgid % nig) / gsz; return true;
    }
    __device__ __forceinline__ void a_ready(const Unit&) const {}
    __device__ __forceinline__ void done(const Unit&) const {}
};

typedef float f32x2_cv __attribute__((ext_vector_type(2))); typedef __bf16 bf16x2_cv __attribute__((ext_vector_type(2)));
__device__ __forceinline__ unsigned cvt_pk_bf16(float lo, float hi) { const f32x2_cv v = {lo, hi}; return __builtin_bit_cast(unsigned, __builtin_convertvector(v, bf16x2_cv)); }
typedef unsigned u32x2 __attribute__((ext_vector_type(2)));
__device__ __forceinline__ float bf_lo(unsigned w) { return __uint_as_float(w << 16); }
__device__ __forceinline__ float bf_hi(unsigned w) { return __uint_as_float(w & 0xffff0000u); }
__device__ __forceinline__ float row_rstd(const float* part, int row, int fq) {
    const f32x4 p = *(const f32x4*)(part + (size_t)row * 16 + 4 * fq);
    float s = (p[0] + p[1]) + (p[2] + p[3]);
    s = xsum32(xsum16(s));
    return rsqrtf(s * (1.0f / 1024.0f) + RMS_EPS);
}
__device__ __forceinline__ float sigmoid_f(float v) { return __builtin_amdgcn_rcpf(1.0f + __expf(-v)); }

struct EpiSwiglu {
    static constexpr bool PERM = true, AFTER_DRAIN = false, HAS_INIT = false; static constexpr int MID_T = 0;
    bf16_t* G; const float* part;
    __device__ __forceinline__ void operator()(const f32x4 (&acc)[2][2][4][2], const Unit& u, int wr, int wc, int fr, int fq) const {
        const int row0 = u.pm * BM + wr * 64 + fr, col0 = u.pn * 128 + wc * 32 + 8 * fq;
#pragma unroll
        for (int ai = 0; ai < 2; ++ai)
#pragma unroll
            for (int m = 0; m < 4; ++m) {
                const int row = row0 + ai * HALF + m * 16; const float rs = row_rstd(part, row, fq);
                f32x4 o[2];
#pragma unroll
                for (int n = 0; n < 2; ++n) { const f32x4 a = acc[ai][0][m][n] * rs, b = acc[ai][1][m][n] * rs;
#pragma unroll
                    for (int j = 0; j < 4; ++j) o[n][j] = a[j] * b[j] * sigmoid_f(a[j]); }
                u32x4 w; w.x = cvt_pk_bf16(o[0][0], o[0][1]); w.y = cvt_pk_bf16(o[0][2], o[0][3]); w.z = cvt_pk_bf16(o[1][0], o[1][1]); w.w = cvt_pk_bf16(o[1][2], o[1][3]);
                __builtin_nontemporal_store(w, (u32x4*)(G + (((size_t)u.pm * (DFF / 64) + (col0 >> 6)) * BM + (row - u.pm * BM)) * 64 + (col0 & 63)));
            }
    }
};
template <bool BASE_BF16> struct EpiResid {
    static constexpr bool PERM = true, AFTER_DRAIN = false, HAS_INIT = true, DUP = false; static constexpr int MID_T = 0;
    const float* base0; const float* base1; const bf16_t* bbase; float* out; bf16_t* xb; float* part; float scale, inv_scale;
    __device__ __forceinline__ void init(f32x4 (&acc)[2][2][4][2], const Unit& u, int wr, int wc, int fr, int fq) const {
        const int row0 = u.pm * BM + wr * 64 + fr, col0 = u.pn * BM + wc * 32 + 8 * fq;
        if constexpr (BASE_BF16) {
#pragma unroll
            for (int ai = 0; ai < 2; ++ai)
#pragma unroll
                for (int m = 0; m < 4; ++m) { const bf16_t* bp = bbase + (size_t)(row0 + ai * HALF + m * 16) * DMODEL + col0;
#pragma unroll
                    for (int bj = 0; bj < 2; ++bj) { const u32x4 w = *(const u32x4*)(bp + bj * HALF);
                        acc[ai][bj][m][0] = (f32x4){bf_lo(w.x), bf_hi(w.x), bf_lo(w.y), bf_hi(w.y)} * inv_scale; acc[ai][bj][m][1] = (f32x4){bf_lo(w.z), bf_hi(w.z), bf_lo(w.w), bf_hi(w.w)} * inv_scale; } }
        } else {
        const float* bp0 = (row0 < T_PROMPT) ? base0 + (size_t)row0 * DMODEL : base1 + (size_t)(row0 - T_PROMPT) * DMODEL;
#pragma unroll
        for (int ai = 0; ai < 2; ++ai)
#pragma unroll
            for (int m = 0; m < 4; ++m) { const float* bp = bp0 + (size_t)(ai * HALF + m * 16) * DMODEL + col0;
#pragma unroll
                for (int bj = 0; bj < 2; ++bj)
#pragma unroll
                    for (int n = 0; n < 2; ++n) acc[ai][bj][m][n] = __builtin_nontemporal_load((const f32x4*)(bp + bj * HALF + 4 * n)) * inv_scale; }
        }
    }
    __device__ __forceinline__ void operator()(const f32x4 (&acc)[2][2][4][2], const Unit& u, int wr, int wc, int fr, int fq) const {
        const int row0 = u.pm * BM + wr * 64 + fr, col0 = u.pn * BM + wc * 32 + 8 * fq;
#pragma unroll
        for (int ai = 0; ai < 2; ++ai)
#pragma unroll
            for (int m = 0; m < 4; ++m) {
                const int row = row0 + ai * HALF + m * 16;
                float ss = 0.f;
#pragma unroll
                for (int bj = 0; bj < 2; ++bj) { const int c = col0 + bj * HALF;
                    const f32x4 v0 = acc[ai][bj][m][0] * scale, v1 = acc[ai][bj][m][1] * scale;
                    if (out) { *(f32x4*)(out + (size_t)row * DMODEL + c) = v0; *(f32x4*)(out + (size_t)row * DMODEL + c + 4) = v1; }
                    ss += (v0[0] * v0[0] + v0[1] * v0[1]) + (v0[2] * v0[2] + v0[3] * v0[3]) + (v1[0] * v1[0] + v1[1] * v1[1]) + (v1[2] * v1[2] + v1[3] * v1[3]);
                    if (xb) { u32x4 w; w.x = cvt_pk_bf16(v0[0], v0[1]); w.y = cvt_pk_bf16(v0[2], v0[3]); w.z = cvt_pk_bf16(v1[0], v1[1]); w.w = cvt_pk_bf16(v1[2], v1[3]);
                        *(u32x4*)(xb + (size_t)row * DMODEL + c) = w; } }
                ss = xsum32(xsum16(ss));
                if (fq == 0) part[(size_t)row * 16 + u.pn * 4 + wc] = ss;
            }
    }
};
struct EpiGate2 {
    static constexpr bool PERM = true, AFTER_DRAIN = false, HAS_INIT = false, DUP = false; static constexpr int MID_T = 4;
    const bf16_t* ga; const bf16_t* gb; bf16_t* out;
    __device__ __forceinline__ void mid(f32x4 (&acc)[2][2][4][2], const Unit& u, int wr, int wc, int fr, int fq) const {
        int oz = 0; asm volatile("" : "+v"(oz));
        const int row0 = u.pm * BM + wr * 64 + fr + oz, col0 = u.pn * BM + wc * 32 + 8 * fq;
#pragma unroll
        for (int ai = 0; ai < 2; ++ai)
#pragma unroll
            for (int m = 0; m < 4; ++m)
#pragma unroll
                for (int bj = 0; bj < 2; ++bj) { const size_t off = (size_t)(row0 + ai * HALF + m * 16) * DMODEL + col0 + bj * HALF;
                    const u32x4 aw = *(const u32x4*)(ga + off), bw = *(const u32x4*)(gb + off);
                    const float a0 = fmaxf(bf_lo(aw.x), 1e-30f), a1 = fmaxf(bf_hi(aw.x), 1e-30f), a2 = fmaxf(bf_lo(aw.y), 1e-30f), a3 = fmaxf(bf_hi(aw.y), 1e-30f);
                    const float a4 = fmaxf(bf_lo(aw.z), 1e-30f), a5 = fmaxf(bf_hi(aw.z), 1e-30f), a6 = fmaxf(bf_lo(aw.w), 1e-30f), a7 = fmaxf(bf_hi(aw.w), 1e-30f);
                    f32x4 v0 = acc[ai][bj][m][0], v1 = acc[ai][bj][m][1];
                    v0[0] *= bf_lo(bw.x) * __builtin_amdgcn_rcpf(a0); v0[1] *= bf_hi(bw.x) * __builtin_amdgcn_rcpf(a1); v0[2] *= bf_lo(bw.y) * __builtin_amdgcn_rcpf(a2); v0[3] *= bf_hi(bw.y) * __builtin_amdgcn_rcpf(a3);
                    v1[0] *= bf_lo(bw.z) * __builtin_amdgcn_rcpf(a4); v1[1] *= bf_hi(bw.z) * __builtin_amdgcn_rcpf(a5); v1[2] *= bf_lo(bw.w) * __builtin_amdgcn_rcpf(a6); v1[3] *= bf_hi(bw.w) * __builtin_amdgcn_rcpf(a7);
                    acc[ai][bj][m][0] = v0; acc[ai][bj][m][1] = v1;
                    if (bj == 1) asm volatile("" ::: "memory"); }
    }
    __device__ __forceinline__ void operator()(const f32x4 (&acc)[2][2][4][2], const Unit& u, int wr, int wc, int fr, int fq) const {
        const int row0 = u.pm * BM + wr * 64 + fr, col0 = u.pn * BM + wc * 32 + 8 * fq;
#pragma unroll
        for (int ai = 0; ai < 2; ++ai)
#pragma unroll
            for (int m = 0; m < 4; ++m)
#pragma unroll
                for (int bj = 0; bj < 2; ++bj) { const size_t off = (size_t)(row0 + ai * HALF + m * 16) * DMODEL + col0 + bj * HALF;
                    const u32x4 aw = *(const u32x4*)(ga + off);
                    f32x4 v0 = acc[ai][bj][m][0], v1 = acc[ai][bj][m][1];
                    v0[0] *= fmaxf(bf_lo(aw.x), 1e-30f); v0[1] *= fmaxf(bf_hi(aw.x), 1e-30f); v0[2] *= fmaxf(bf_lo(aw.y), 1e-30f); v0[3] *= fmaxf(bf_hi(aw.y), 1e-30f);
                    v1[0] *= fmaxf(bf_lo(aw.z), 1e-30f); v1[1] *= fmaxf(bf_hi(aw.z), 1e-30f); v1[2] *= fmaxf(bf_lo(aw.w), 1e-30f); v1[3] *= fmaxf(bf_hi(aw.w), 1e-30f);
                    u32x4 w; w.x = cvt_pk_bf16(v0[0], v0[1]); w.y = cvt_pk_bf16(v0[2], v0[3]); w.z = cvt_pk_bf16(v1[0], v1[1]); w.w = cvt_pk_bf16(v1[2], v1[3]);
                    *(u32x4*)(out + off) = w; }
    }
};
struct EpiProj {
    static constexpr bool PERM = false, AFTER_DRAIN = false, HAS_INIT = false, DUP = false; static constexpr int MID_T = 0;
    bf16_t *QA, *KA, *VA, *QB, *KB, *VB, *GA, *GB; const float *cosA, *sinA, *cosB, *sinB, *qkn, *part;
    __device__ __forceinline__ void operator()(const f32x4 (&acc)[2][2][4][2], const Unit& u, int wr, int wc, int fr, int fq) const {
        const int pn = u.pn; int kind; bf16_t* dst; int pitch, colbase, hB = -1;
        if (pn < 2) { kind = 0; dst = QA; pitch = 512; colbase = (pn * 4 + wc) * 64; }
        else if (pn == 2) { if (wc < 2) { kind = 1; dst = KA; pitch = 128; colbase = wc * 64; } else { kind = 4; dst = VA; pitch = 128; colbase = (wc - 2) * 64; } }
        else if (pn < 6) { kind = 2; dst = QB; hB = (pn - 3) * 4 + wc; pitch = 64; colbase = 0; }
        else if (pn < 9) { kind = 3; dst = KB; hB = (pn - 6) * 4 + wc; pitch = 64; colbase = 0; }
        else if (pn < 12) { kind = 4; dst = VB; hB = (pn - 9) * 4 + wc; pitch = 64; colbase = 0; }
        else if (pn < 16) { kind = 5; dst = GA; pitch = 1024; colbase = (pn - 12) * 256 + wc * 64; }
        else { kind = 5; dst = GB; pitch = 1024; colbase = (pn - 16) * 256 + wc * 64; }
        const int row0 = u.pm * BM + wr * 64 + fr;
        const int S = (row0 < T_PROMPT) ? 4096 : 8192;
        const int sh = hB >= 0 ? 2 * (hB >> 2) : 0;
        float rsv[8];
#pragma unroll
        for (int i = 0; i < 8; ++i) rsv[i] = row_rstd(part, row0 + (i >> 2) * HALF + (i & 3) * 16, fq);
#pragma unroll
        for (int ai = 0; ai < 2; ++ai)
#pragma unroll
            for (int m = 0; m < 4; ++m) {
                const int row = row0 + ai * HALF + m * 16; const float rs = rsv[ai * 4 + m];
                const int t = row & (S - 1);
                f32x4 v[2][2];
#pragma unroll
                for (int bj = 0; bj < 2; ++bj)
#pragma unroll
                    for (int n = 0; n < 2; ++n) v[bj][n] = acc[ai][bj][m][n] * rs;
                if (kind <= 1) {
                    const float* gp = qkn + kind * 64;
                    float ss = 0.f;
#pragma unroll
                    for (int bj = 0; bj < 2; ++bj)
#pragma unroll
                        for (int n = 0; n < 2; ++n) ss += (v[bj][n][0] * v[bj][n][0] + v[bj][n][1] * v[bj][n][1]) + (v[bj][n][2] * v[bj][n][2] + v[bj][n][3] * v[bj][n][3]);
                    ss = xsum32(xsum16(ss));
                    const float hr = rsqrtf(ss * (1.0f / 64.0f) + RMS_EPS) * (kind == 0 ? QK_C2 : 1.0f);
#pragma unroll
                    for (int bj = 0; bj < 2; ++bj) { const int pos = bj == 0 ? (t >> 6) : (t & 63);
                        const f32x4 c = *(const f32x4*)(cosA + pos * 16 + 4 * fq), s = *(const f32x4*)(sinA + pos * 16 + 4 * fq);
                        const f32x4 x1 = v[bj][0] * *(const f32x4*)(gp + 32 * bj + 4 * fq) * hr, x2 = v[bj][1] * *(const f32x4*)(gp + 32 * bj + 16 + 4 * fq) * hr;
                        v[bj][0] = x1 * c - x2 * s; v[bj][1] = x2 * c + x1 * s; }
                } else if (kind <= 3) {
                    const int fi = fq < 2 ? fq : 0;
                    f32x4 c = *(const f32x4*)(cosB + t * 8 + 4 * fi), s = *(const f32x4*)(sinB + t * 8 + 4 * fi);
                    if (fq >= 2) { c = (f32x4){1.f, 1.f, 1.f, 1.f}; s = (f32x4){0.f, 0.f, 0.f, 0.f}; }
                    const f32x4 x1 = v[0][0], x2 = v[0][1];
                    v[0][0] = x1 * c - x2 * s; v[0][1] = x2 * c + x1 * s;
                    if (kind == 2) {
#pragma unroll
                        for (int bj = 0; bj < 2; ++bj)
#pragma unroll
                            for (int n = 0; n < 2; ++n) v[bj][n] = v[bj][n] * QK_C2; }
                } else if (kind == 5) {
#pragma unroll
                    for (int bj = 0; bj < 2; ++bj)
#pragma unroll
                        for (int n = 0; n < 2; ++n)
#pragma unroll
                            for (int j = 0; j < 4; ++j) v[bj][n][j] = sigmoid_f(v[bj][n][j]);
                }
                size_t roff;
                if (hB >= 0) { const int perm = (t & ((1 << sh) - 1)) * (S >> sh) + (t >> sh); roff = ((size_t)hB * T_ROWS + (size_t)(row - t) + perm) * 64; }
                else roff = (size_t)row * pitch + colbase;
                bf16_t* rp = dst + roff + 8 * fq;
#pragma unroll
                for (int bj = 0; bj < 2; ++bj) { u32x4 w; w.x = cvt_pk_bf16(v[bj][0][0], v[bj][0][1]); w.y = cvt_pk_bf16(v[bj][0][2], v[bj][0][3]); w.z = cvt_pk_bf16(v[bj][1][0], v[bj][1][1]); w.w = cvt_pk_bf16(v[bj][1][2], v[bj][1][3]);
                    *(u32x4*)(rp + 32 * bj) = w; }
            }
    }
};
template <class Epi, class Sched, bool ALIGN_EPI = false, bool SP2 = false, bool ATILED = false>
__device__ __forceinline__ void gemm_phase(PG8_LAS unsigned char* lds, const Gemm g, const Sched& S, const Epi& E) {
    const int tid = opaque_tid(), wid = __builtin_amdgcn_readfirstlane(tid >> 6), lane = tid & 63, wr = wid >> 2, wc = wid & 3, fr = lane & 15, fq = lane >> 4;
    const int K = g.K, nt = K / BK;
    unsigned voffA[2], voffB[2];
#pragma unroll
    for (int i = 0; i < 2; ++i) { int R, C; stage_rc(tid * 16 + i * 8192, R, C); const int Rb = Epi::PERM ? ((R & ~31) + perm32(R & 31)) : R;
        voffA[i] = (unsigned)(R * (ATILED ? BK : K) + C) * 2u; voffB[i] = (unsigned)(Rb * K + C) * 2u; }
    const size_t kstep = (size_t)(BK * 2);
    const size_t hstep = (size_t)HALF * K * 2;
    const size_t kstepA = ATILED ? (size_t)BM * BK * 2 : kstep, hstepA = ATILED ? (size_t)HALF * BK * 2 : hstep;
    const size_t tstep = 2 * hstep;
    const unsigned ldsw = (unsigned)wid * 1024u;
    const int aoff = lds_byte(wr * 64 + fr, fq * 8), boff = lds_byte(wc * 32 + fr, fq * 8);
#define PG8_SA(b, h) (((b) * 2 + (h)) * HTB)
#define PG8_SB(b, h) ((4 + (b) * 2 + (h)) * HTB)
#define PG8_STAGE(bufoff, gbase, voff) do { _Pragma("unroll") for (int _i = 0; _i < 2; ++_i) \
        __builtin_amdgcn_global_load_lds((const unsigned*)((const char*)(gbase) + (voff)[_i]), (PG8_LAS unsigned*)(lds + (bufoff) + ldsw + _i * 8192), 16, 0, 0); } while (0)
#define PG8_LDA(dst, b, h) do { _Pragma("unroll") for (int m = 0; m < 4; ++m) _Pragma("unroll") for (int k = 0; k < 2; ++k) dst[m][k] = *(const PG8_LAS bf16x8*)(lds + PG8_SA(b, h) + aoff + m * 2048 + k * 1024); } while (0)
#define PG8_LDB(dst, b, h) do { _Pragma("unroll") for (int n = 0; n < 2; ++n) _Pragma("unroll") for (int k = 0; k < 2; ++k) dst[n][k] = *(const PG8_LAS bf16x8*)(lds + PG8_SB(b, h) + boff + n * 2048 + k * 1024); } while (0)
#define PG8_MMA(ai, bj, At, Bt) do { __builtin_amdgcn_s_setprio(1); _Pragma("unroll") for (int m = 0; m < 4; ++m) _Pragma("unroll") for (int n = 0; n < 2; ++n) _Pragma("unroll") for (int k = 0; k < 2; ++k) \
        acc[ai][bj][m][n] = __builtin_amdgcn_mfma_f32_16x16x32_bf16(Bt[n][k], At[m][k], acc[ai][bj][m][n], 0, 0, 0); __builtin_amdgcn_s_setprio(0); } while (0)
#define PG8_WAIT_V(n) asm volatile("s_waitcnt vmcnt(" #n ")" ::: "memory")
#define PG8_WAIT_L(n) asm volatile("s_waitcnt lgkmcnt(" #n ")" ::: "memory")
#define PG8_BAR __builtin_amdgcn_s_barrier()
#define PG8_SCHED __builtin_amdgcn_sched_barrier(0)
    Unit cur, nxt; int ui = 0;
    if (!S.next(0, cur)) return;
    f32x4 acc[2][2][4][2];
    if constexpr (Epi::HAS_INIT) E.init(acc, cur, wr, wc, fr, fq);
    else {
#pragma unroll
    for (int a = 0; a < 2; ++a)
#pragma unroll
        for (int b = 0; b < 2; ++b)
#pragma unroll
            for (int m = 0; m < 4; ++m)
#pragma unroll
                for (int n = 0; n < 2; ++n) acc[a][b][m][n] = (f32x4){0.f, 0.f, 0.f, 0.f};
    }
    bf16x8 At[4][2], B0[2][2], B1[2][2];
    const char* cA = (const char*)g.A + (size_t)cur.pm * tstep; const char* cB = (const char*)g.Bt + (size_t)cur.pn * tstep;
    S.a_ready(cur);
    if constexpr (SP2) {
        PG8_STAGE(PG8_SB(0, 0), cB, voffB); PG8_STAGE(PG8_SB(0, 1), cB + hstep, voffB); PG8_STAGE(PG8_SA(0, 0), cA, voffA); PG8_STAGE(PG8_SA(0, 1), cA + hstepA, voffA);
        if (wr == 1) PG8_BAR;
        PG8_WAIT_V(2); PG8_BAR;
        PG8_STAGE(PG8_SB(1, 0), cB + kstep, voffB); PG8_STAGE(PG8_SA(1, 0), cA + kstepA, voffA); PG8_STAGE(PG8_SB(1, 1), cB + hstep + kstep, voffB);
        PG8_WAIT_V(6); PG8_BAR;
    } else {
        PG8_STAGE(PG8_SB(0, 0), cB, voffB); PG8_STAGE(PG8_SA(0, 0), cA, voffA); PG8_STAGE(PG8_SB(0, 1), cB + hstep, voffB); PG8_STAGE(PG8_SA(0, 1), cA + hstepA, voffA);
        if (wr == 1) PG8_BAR;
        PG8_WAIT_V(4); PG8_BAR;
        PG8_STAGE(PG8_SB(1, 0), cB + kstep, voffB); PG8_STAGE(PG8_SA(1, 0), cA + kstepA, voffA); PG8_STAGE(PG8_SB(1, 1), cB + hstep + kstep, voffB);
        PG8_WAIT_V(6); PG8_BAR;
    }
    for (;;) {
        const bool has_next = S.next(ui + 1, nxt);
        const char* nA = has_next ? (const char*)g.A + (size_t)nxt.pm * tstep : cA; const char* nB = has_next ? (const char*)g.Bt + (size_t)nxt.pn * tstep : cB;
        for (int t = 0; t < nt; t += 2) {
            if constexpr (Epi::MID_T > 0) { if (t == Epi::MID_T) E.mid(acc, cur, wr, wc, fr, fq); }
            const bool last = (t == nt - 2);
            const char* a1 = cA + (size_t)(t + 1) * kstepA;
            const char* a2 = last ? nA : cA + (size_t)(t + 2) * kstepA; const char* b2 = last ? nB : cB + (size_t)(t + 2) * kstep;
            const char* a3 = a2 + kstepA; const char* b3 = b2 + kstep;
            if (last && has_next) S.a_ready(nxt);
            if constexpr (SP2) {
            PG8_LDB(B0, 0, 0); PG8_LDB(B1, 0, 1); PG8_SCHED; PG8_LDA(At, 0, 0); PG8_STAGE(PG8_SA(1, 1), a1 + hstepA, voffA);
            PG8_WAIT_V(8); PG8_WAIT_L(0); PG8_BAR; PG8_MMA(0, 0, At, B0); PG8_MMA(0, 1, At, B1); PG8_BAR; PG8_SCHED;
            PG8_LDA(At, 0, 1); PG8_STAGE(PG8_SB(0, 0), b2, voffB); PG8_STAGE(PG8_SB(0, 1), b2 + hstep, voffB); PG8_STAGE(PG8_SA(0, 0), a2, voffA);
            PG8_WAIT_V(8); PG8_WAIT_L(0); PG8_BAR; PG8_MMA(1, 0, At, B0); PG8_MMA(1, 1, At, B1); PG8_BAR; PG8_SCHED;
            PG8_LDB(B0, 1, 0); PG8_LDB(B1, 1, 1); PG8_SCHED; PG8_LDA(At, 1, 0); PG8_STAGE(PG8_SA(0, 1), a2 + hstepA, voffA);
            PG8_WAIT_V(8); PG8_WAIT_L(0); PG8_BAR; PG8_MMA(0, 0, At, B0); PG8_MMA(0, 1, At, B1); PG8_BAR; PG8_SCHED;
            PG8_LDA(At, 1, 1); PG8_STAGE(PG8_SB(1, 0), b3, voffB); PG8_STAGE(PG8_SB(1, 1), b3 + hstep, voffB); PG8_STAGE(PG8_SA(1, 0), a3, voffA);
            PG8_WAIT_V(8); PG8_WAIT_L(0); PG8_BAR; PG8_MMA(1, 0, At, B0); PG8_MMA(1, 1, At, B1); PG8_BAR; PG8_SCHED;
            } else {
            PG8_LDB(B0, 0, 0); PG8_SCHED; PG8_LDA(At, 0, 0); PG8_STAGE(PG8_SA(1, 1), a1 + hstepA, voffA);
            PG8_WAIT_L(8); PG8_BAR; PG8_WAIT_L(0); PG8_MMA(0, 0, At, B0); PG8_BAR; PG8_SCHED;
            PG8_LDB(B1, 0, 1); PG8_STAGE(PG8_SB(0, 0), b2, voffB);
            PG8_BAR; PG8_WAIT_L(0); PG8_MMA(0, 1, At, B1); PG8_BAR;
            PG8_LDA(At, 0, 1); PG8_STAGE(PG8_SA(0, 0), a2, voffA);
            PG8_BAR; PG8_WAIT_L(0); PG8_MMA(1, 0, At, B0); PG8_BAR; PG8_SCHED;
            PG8_STAGE(PG8_SB(0, 1), b2 + hstep, voffB);
            PG8_WAIT_V(6); PG8_BAR; PG8_MMA(1, 1, At, B1); PG8_BAR;
            PG8_LDB(B0, 1, 0); PG8_SCHED; PG8_LDA(At, 1, 0); PG8_STAGE(PG8_SA(0, 1), a2 + hstepA, voffA);
            PG8_WAIT_L(8); PG8_BAR; PG8_WAIT_L(0); PG8_MMA(0, 0, At, B0); PG8_BAR; PG8_SCHED;
            PG8_LDB(B1, 1, 1); PG8_STAGE(PG8_SB(1, 0), b3, voffB);
            PG8_BAR; PG8_WAIT_L(0); PG8_MMA(0, 1, At, B1); PG8_BAR;
            PG8_LDA(At, 1, 1); PG8_STAGE(PG8_SA(1, 0), a3, voffA);
            PG8_BAR; PG8_WAIT_L(0); PG8_MMA(1, 0, At, B0); PG8_BAR; PG8_SCHED;
            PG8_STAGE(PG8_SB(1, 1), b3 + hstep, voffB);
            PG8_WAIT_V(6); PG8_BAR; PG8_MMA(1, 1, At, B1); PG8_BAR;
            }
        }
        if constexpr (ALIGN_EPI) { if (wr == 0) PG8_BAR; }
        if constexpr (!Epi::AFTER_DRAIN) { E(acc, cur, wr, wc, fr, fq); S.done(cur); }
        if (!has_next) break;
        if constexpr (Epi::HAS_INIT) E.init(acc, nxt, wr, wc, fr, fq);
        else {
#pragma unroll
        for (int a = 0; a < 2; ++a)
#pragma unroll
            for (int b = 0; b < 2; ++b)
#pragma unroll
                for (int m = 0; m < 4; ++m)
#pragma unroll
                    for (int n = 0; n < 2; ++n) acc[a][b][m][n] = (f32x4){0.f, 0.f, 0.f, 0.f};
        }
        cur = nxt; cA = nA; cB = nB; ++ui;
        if constexpr (ALIGN_EPI) { if (wr == 1) PG8_BAR; }
    }
    PG8_WAIT_V(0);
    if constexpr (!ALIGN_EPI) { if (wr == 0) PG8_BAR; }
    PG8_BAR;
    if constexpr (Epi::AFTER_DRAIN) { E.fused(acc, cur, wr, wc, fr, fq, lds, wid, lane); S.done(cur); }
#undef PG8_SA
#undef PG8_SB
#undef PG8_STAGE
#undef PG8_LDA
#undef PG8_LDB
#undef PG8_MMA
#undef PG8_WAIT_V
#undef PG8_WAIT_L
#undef PG8_BAR
#undef PG8_SCHED
}
}
#include <hip/hip_bf16.h>
#include <cmath>
namespace attn_body {
using bf16=__hip_bfloat16;
using bf16x8=__attribute__((ext_vector_type(8)))short;
using s16x4=__attribute__((ext_vector_type(4)))short;
using f32x16=__attribute__((ext_vector_type(16)))float;
using u32x4=__attribute__((ext_vector_type(4)))unsigned;
constexpr int D=64,QP=512,KP=128,OPT=768,OCOL=256;
constexpr int NW=8,QBLK=32,QB=QBLK*NW,KVBLK=64;

__device__ __forceinline__ int crow(int r,int hi){return (r&3)+8*(r>>2)+4*hi;}
#define SBAR() __builtin_amdgcn_sched_barrier(0)
__device__ __forceinline__ void cmask(f32x16&p0,f32x16&p1,int jb,int qrel,int hi){
  const float NEG=-INFINITY; int kb=64*jb+4*hi;
  #pragma unroll
  for(int r=0;r<16;++r){int kv=kb+(r&3)+8*(r>>2); if(kv>qrel)p0[r]=NEG; if(kv+32>qrel)p1[r]=NEG;}
}

constexpr int NSLOT=3, SLOTB=8192;
constexpr int LDS_K=0, LDS_V=NSLOT*SLOTB, LDS_WS=2*NSLOT*SLOTB, LDS_OST=LDS_WS+NW*64*4, LDS_BYTES=LDS_OST+NW*4096;
constexpr float C2=0.125f*1.4426950408889634f;
__device__ __forceinline__ void glds16(const void*gsrc,unsigned lds_dst){unsigned keep;
  asm volatile("s_mov_b32 %0, m0\n\ts_mov_b32 m0, %2\n\ts_nop 0\n\tglobal_load_lds_dwordx4 %1, off\n\ts_mov_b32 m0, %0":"=&s"(keep):"v"(gsrc),"s"(lds_dst):"memory");}
__device__ __forceinline__ float max3f(float a,float b,float c){float r;asm("v_max3_f32 %0, %1, %2, %3":"=v"(r):"v"(a),"v"(b),"v"(c));return r;}
__device__ __forceinline__ float max2f(float a,float b){float r;asm("v_max_f32_e32 %0, %1, %2":"=v"(r):"v"(a),"v"(b));return r;}
__device__ __forceinline__ float fadd_s(float a,float b){float r;asm("v_add_f32_e32 %0, %1, %2":"=v"(r):"v"(a),"v"(b));return r;}
__device__ __forceinline__ float fsub_s(float a,float b){float r;asm("v_sub_f32_e32 %0, %1, %2":"=v"(r):"v"(a),"v"(b));return r;}
typedef float f32x2_t __attribute__((ext_vector_type(2))); typedef __bf16 bf16x2_t __attribute__((ext_vector_type(2)));
__device__ __forceinline__ unsigned cvtpk_s(float lo,float hi){f32x2_t v={lo,hi};bf16x2_t b=__builtin_convertvector(v,bf16x2_t);return __builtin_bit_cast(unsigned,b);}
#define WAIT_BAR(N) asm volatile("s_waitcnt vmcnt(" #N ") lgkmcnt(0)\n\ts_barrier":::"memory")

__device__ __forceinline__ void qkt(f32x16&p0,f32x16&p1,const char*Kslot,const bf16x8*qr,const f32x16&negm,int r32,int hi){
  const char*kb=Kslot+hi*1024+r32*16;
  #pragma unroll
  for(int d0=0;d0<4;++d0){
    const bf16x8 b0=*reinterpret_cast<const bf16x8*>(kb+d0*2048);
    const bf16x8 b1=*reinterpret_cast<const bf16x8*>(kb+d0*2048+512);
    if(d0==0){p0=__builtin_amdgcn_mfma_f32_32x32x16_bf16(b0,qr[0],negm,0,0,0);p1=__builtin_amdgcn_mfma_f32_32x32x16_bf16(b1,qr[0],negm,0,0,0);}
    else{p0=__builtin_amdgcn_mfma_f32_32x32x16_bf16(b0,qr[d0],p0,0,0,0);p1=__builtin_amdgcn_mfma_f32_32x32x16_bf16(b1,qr[d0],p1,0,0,0);}}
}
typedef __attribute__((address_space(3))) const char* lds_cptr;
typedef short v4i16_t __attribute__((ext_vector_type(4)));
__device__ __forceinline__ void kload8(bf16x8*kf,lds_cptr kp){
  kf[0]=*(const __attribute__((address_space(3))) bf16x8*)(kp);      kf[1]=*(const __attribute__((address_space(3))) bf16x8*)(kp+512);
  kf[2]=*(const __attribute__((address_space(3))) bf16x8*)(kp+2048); kf[3]=*(const __attribute__((address_space(3))) bf16x8*)(kp+2560);
  kf[4]=*(const __attribute__((address_space(3))) bf16x8*)(kp+4096); kf[5]=*(const __attribute__((address_space(3))) bf16x8*)(kp+4608);
  kf[6]=*(const __attribute__((address_space(3))) bf16x8*)(kp+6144); kf[7]=*(const __attribute__((address_space(3))) bf16x8*)(kp+6656);
}
__device__ __forceinline__ void kload2(bf16x8*kf,lds_cptr kp,int j){ kf[2*j]=*(const __attribute__((address_space(3))) bf16x8*)(kp+j*2048); kf[2*j+1]=*(const __attribute__((address_space(3))) bf16x8*)(kp+j*2048+512); }
__device__ __forceinline__ s16x4 vtr(lds_cptr p){ return __builtin_bit_cast(s16x4,__builtin_amdgcn_ds_read_tr16_b64_v4i16((__attribute__((address_space(3))) v4i16_t*)p)); }
__device__ __forceinline__ float rowmax(const f32x16&p0,const f32x16&p1){
  float a=max3f(p0[0],p0[1],p1[0]),b=max3f(p0[2],p0[3],p1[1]);a=max3f(a,p1[2],p1[3]);
  #pragma unroll
  for(int r=4;r<16;r+=4){a=max3f(a,p0[r],p0[r+1]);b=max3f(b,p0[r+2],p0[r+3]);a=max3f(a,p1[r],p1[r+1]);b=max3f(b,p1[r+2],p1[r+3]);}
  const float m=max2f(a,b);
  auto rr=__builtin_amdgcn_permlane32_swap(__float_as_uint(m),__float_as_uint(m),false,false);
  return max2f(__uint_as_float(rr[0]),__uint_as_float(rr[1]));
}
__device__ __forceinline__ void pv(f32x16*o,int vb,bf16x8 pa0,bf16x8 pa1,bf16x8 pa2,bf16x8 pa3){
  #pragma unroll
  for(int d0=0;d0<2;++d0){s16x4 lo[4],hi[4];
    #pragma unroll
    for(int ks=0;ks<4;++ks){
      asm volatile("ds_read_b64_tr_b16 %0,%1 offset:%c2":"=&v"(lo[ks]):"v"(vb),"i"(d0*4096+ks*1024):"memory");
      asm volatile("ds_read_b64_tr_b16 %0,%1 offset:%c2":"=&v"(hi[ks]):"v"(vb),"i"(d0*4096+ks*1024+512):"memory");}
    asm volatile("s_waitcnt lgkmcnt(0)":::"memory");SBAR();
    #define PK(k) (bf16x8){lo[k][0],lo[k][1],lo[k][2],lo[k][3],hi[k][0],hi[k][1],hi[k][2],hi[k][3]}
    o[d0]=__builtin_amdgcn_mfma_f32_32x32x16_bf16(pa0,PK(0),o[d0],0,0,0);
    o[d0]=__builtin_amdgcn_mfma_f32_32x32x16_bf16(pa1,PK(1),o[d0],0,0,0);
    o[d0]=__builtin_amdgcn_mfma_f32_32x32x16_bf16(pa2,PK(2),o[d0],0,0,0);
    o[d0]=__builtin_amdgcn_mfma_f32_32x32x16_bf16(pa3,PK(3),o[d0],0,0,0);
    #undef PK
  }
}

#ifndef ATTN_STORE16
#define ATTN_STORE16(p,v) (*(u32x4*)(p)=(v))
#endif
template<int THRL> __device__ __forceinline__ void attn_unit(long rowbase,int S,int h,int q0,const bf16*Q,const bf16*__restrict__ K,const bf16*__restrict__ V,bf16*O,char*shm){
  const int tid=opaque_tid(),lane=tid&63,r32=lane&31,hi=lane>>5; const int wid=__builtin_amdgcn_readfirstlane(tid>>6);
  const int hk=h>>2;
  const bf16*Qw=Q+(rowbase+q0+wid*QBLK)*QP+h*D;
  const bf16*Kh=K+rowbase*KP+hk*D,*Vh=V+rowbase*KP+hk*D;
  const unsigned lds0=(unsigned)(uintptr_t)shm;
  float*wsf=(float*)(shm+LDS_WS)+wid*64;
  const bf16*ksrc=Kh+(long)lane*KP+wid*8;
  const bf16*vsrc=Vh+(long)(16*(wid&3)+(lane>>2))*KP+(wid>>2)*32+(lane&3)*8;
  const unsigned kdst=lds0+LDS_K+wid*1024, vdst=lds0+LDS_V+wid*1024;
  #define DMA_K(t,slot) glds16(ksrc+(long)(t)*KVBLK*KP,(unsigned)__builtin_amdgcn_readfirstlane(kdst+(slot)))
  #define DMA_V(t,slot) glds16(vsrc+(long)(t)*KVBLK*KP,(unsigned)__builtin_amdgcn_readfirstlane(vdst+(slot)))
  const int vb0=(int)(lds0+LDS_V)+((lane>>4)&1)*32+(lane&3)*8+(4*hi+((lane&15)>>2))*64;
  const char*Kbase=shm+LDS_K; bf16x8 kf[8];
  const lds_cptr shm3=(lds_cptr)shm; const lds_cptr kp0=shm3+LDS_K+hi*1024+r32*16; const lds_cptr vp0=shm3+LDS_V+((lane>>4)&1)*32+(lane&3)*8+(4*hi+((lane&15)>>2))*64;
  const int NT=S/KVBLK;
  DMA_K(0,0);DMA_V(0,0);DMA_K(1,SLOTB);
  bf16x8 qr[4];
  #pragma unroll
  for(int d0=0;d0<4;++d0)qr[d0]=*reinterpret_cast<const bf16x8*>(&Qw[(long)r32*QP+d0*16+hi*8]);
  float mhat=0.f,l_reg=0.f;f32x16 o[2];o[0]=f32x16{};o[1]=f32x16{};f32x16 negm=f32x16{};asm volatile("":"+v"(negm));
  const int qrel=wid*QBLK+r32;
  #define CMASK(P0,P1,t) do{}while(0)
  bool resc=false;
  #define START(P0,P1) do{ const float rm=rowmax(P0,P1); resc=false; \
    { const float dl=rm; mhat=fadd_s(mhat,dl); \
      _Pragma("unroll") for(int r=0;r<16;++r){P0[r]=fsub_s(P0[r],dl);P1[r]=fsub_s(P1[r],dl);} \
      _Pragma("unroll") for(int r=0;r<16;++r)negm[r]=-mhat; asm volatile("":"+v"(negm)); } \
    _Pragma("unroll") for(int r=0;r<16;++r)P0[r]=__builtin_amdgcn_exp2f(P0[r]); }while(0)
  #define RESC() do{ if(resc){ asm volatile("s_waitcnt lgkmcnt(0)":::"memory"); \
      _Pragma("unroll") for(int d_=0;d_<2;++d_) _Pragma("unroll") for(int r=0;r<16;++r)o[d_][r]*=wsf[crow(r,hi)]; } }while(0)
  f32x16 pA0,pA1,pB0,pB1;
  int sl_prev=0,sl_cur=0,sl_next=SLOTB;
  #define ROT() do{sl_prev=sl_cur;sl_cur=sl_next;sl_next=(sl_next==(NSLOT-1)*SLOTB)?0:sl_next+SLOTB;}while(0)
  DMA_K(2,2*SLOTB);
  WAIT_BAR(3);
  qkt(pA0,pA1,Kbase,qr,negm,r32,hi);asm volatile("s_nop 15\n\ts_nop 7":"+v"(pA0),"+v"(pA1));CMASK(pA0,pA1,0);
  START(pA0,pA1);
  _Pragma("unroll") for(int r=0;r<16;++r)pA1[r]=__builtin_amdgcn_exp2f(pA1[r]);
  WAIT_BAR(0);
  DMA_K(3,0);DMA_V(1,SLOTB);
  ROT();
  kload8(kf,kp0+sl_cur);
  WAIT_BAR(2);
  s16x4 vlo[8],vhi[8]; u32x4 pw0,pw1,pw2,pw3;
  #define PKW(P,B) cvtpk_s(P[B],P[B+1])
  #define PAF(k) __builtin_bit_cast(bf16x8,pw##k)
  #define VFR(i) (bf16x8){vlo[i][0],vlo[i][1],vlo[i][2],vlo[i][3],vhi[i][0],vhi[i][1],vhi[i][2],vhi[i][3]}
  #define PIN(x) asm volatile("":"+v"(x))
  #define MX3(a,b,c) __builtin_fmaxf(__builtin_fmaxf((a),(b)),(c))
  #define GAPA(MF,A0,A1,A2,A3,W0,W1,PW) do{ MF; sacc+=A0; sacc+=A1; sacc+=A2; sacc+=A3; PIN(sacc); W0; W1; PIN(PW); SBAR(); }while(0)
  #define EX(v) __builtin_amdgcn_exp2f(v)
  #define GAPB(MF,X,B) do{ MF; X[B]=EX(X[B]); X[B+1]=EX(X[B+1]); X[B+2]=EX(X[B+2]); X[B+3]=EX(X[B+3]); PIN(X); SBAR(); }while(0)
  #define VRD(i) do{ vlo[i]=vtr(vp_+(((i)>>2)*4096+((i)&3)*1024)); vhi[i]=vtr(vp_+(((i)>>2)*4096+((i)&3)*1024+512)); }while(0)
  #define KRD(G,j) do{ if(G){ kload2(kf,kp0+sl_next,j); SBAR(); } }while(0)
  #define STEP(C0,C1,P0,P1,t,GK,GV,GL) do{ SBAR(); \
    const lds_cptr vp_=vp0+sl_prev; \
    VRD(0); SBAR(); float sacc=(P0[0]+P0[1]); \
    GAPA(C0=__builtin_amdgcn_mfma_f32_32x32x16_bf16(kf[0],qr[0],negm,0,0,0), P0[2],P0[3],P0[4],P0[5],     pw0[0]=PKW(P0,0), pw0[1]=PKW(P0,2), pw0); \
    VRD(4); SBAR(); GAPA(C1=__builtin_amdgcn_mfma_f32_32x32x16_bf16(kf[1],qr[0],negm,0,0,0), P0[6],P0[7],P0[8],P0[9],     pw0[2]=PKW(P0,4), pw0[3]=PKW(P0,6), pw0); \
    VRD(1); SBAR(); GAPA(C0=__builtin_amdgcn_mfma_f32_32x32x16_bf16(kf[2],qr[1],C0,0,0,0),   P0[10],P0[11],P0[12],P0[13], pw1[0]=PKW(P0,8), pw1[1]=PKW(P0,10), pw1); \
    VRD(5); SBAR(); GAPA(C1=__builtin_amdgcn_mfma_f32_32x32x16_bf16(kf[3],qr[1],C1,0,0,0),   P0[14],P0[15],P1[0],P1[1],   pw1[2]=PKW(P0,12),pw1[3]=PKW(P0,14), pw1); \
    VRD(2); SBAR(); GAPA(C0=__builtin_amdgcn_mfma_f32_32x32x16_bf16(kf[4],qr[2],C0,0,0,0),   P1[2],P1[3],P1[4],P1[5],     pw2[0]=PKW(P1,0), pw2[1]=PKW(P1,2), pw2); \
    VRD(6); SBAR(); GAPA(C1=__builtin_amdgcn_mfma_f32_32x32x16_bf16(kf[5],qr[2],C1,0,0,0),   P1[6],P1[7],P1[8],P1[9],     pw2[2]=PKW(P1,4), pw2[3]=PKW(P1,6), pw2); \
    VRD(3); SBAR(); GAPA(C0=__builtin_amdgcn_mfma_f32_32x32x16_bf16(kf[6],qr[3],C0,0,0,0),   P1[10],P1[11],P1[12],P1[13], pw3[0]=PKW(P1,8), pw3[1]=PKW(P1,10), pw3); \
    VRD(7); SBAR(); GAPA(C1=__builtin_amdgcn_mfma_f32_32x32x16_bf16(kf[7],qr[3],C1,0,0,0),   P1[14],P1[15],0.f,0.f,       pw3[2]=PKW(P1,12),pw3[3]=PKW(P1,14), pw3); \
    l_reg+=sacc; \
    if(GK){DMA_K((t)+3,sl_cur);} if(GV){DMA_V((t)+1,sl_next);} \
    CMASK(C0,C1,t); \
    { float a=MX3(C0[0],C0[1],C1[0]),b=MX3(C0[2],C0[3],C1[1]); a=MX3(a,C1[2],C1[3]); \
      _Pragma("unroll") for(int r=4;r<16;r+=4){a=MX3(a,C0[r],C0[r+1]);b=MX3(b,C0[r+2],C0[r+3]);a=MX3(a,C1[r],C1[r+1]);b=MX3(b,C1[r+2],C1[r+3]);} \
      float rm=__builtin_fmaxf(a,b); { auto rr=__builtin_amdgcn_permlane32_swap(__float_as_uint(rm),__float_as_uint(rm),false,false); rm=__builtin_fmaxf(__uint_as_float(rr[0]),__uint_as_float(rr[1])); } \
      resc=false; \
      if(__builtin_expect(__any(rm>(float)THRL),0)){ const float dl=__builtin_fmaxf(rm,0.f); mhat+=dl; \
        _Pragma("unroll") for(int r=0;r<16;++r){C0[r]-=dl;C1[r]-=dl;} \
        _Pragma("unroll") for(int r=0;r<16;++r)negm[r]=-mhat; asm volatile("":"+v"(negm)); \
        const float f=__builtin_amdgcn_exp2f(-dl); l_reg*=f; if(hi==0)wsf[r32]=f; resc=true; } } \
    SBAR(); \
    GAPB(o[0]=__builtin_amdgcn_mfma_f32_32x32x16_bf16(PAF(0),VFR(0),o[0],0,0,0), C0,0); \
    GAPB(o[1]=__builtin_amdgcn_mfma_f32_32x32x16_bf16(PAF(0),VFR(4),o[1],0,0,0), C0,4); \
    KRD(GL,0); GAPB(o[0]=__builtin_amdgcn_mfma_f32_32x32x16_bf16(PAF(1),VFR(1),o[0],0,0,0), C0,8); \
    KRD(GL,1); GAPB(o[1]=__builtin_amdgcn_mfma_f32_32x32x16_bf16(PAF(1),VFR(5),o[1],0,0,0), C0,12); \
    KRD(GL,2); GAPB(o[0]=__builtin_amdgcn_mfma_f32_32x32x16_bf16(PAF(2),VFR(2),o[0],0,0,0), C1,0); \
    KRD(GL,3); GAPB(o[1]=__builtin_amdgcn_mfma_f32_32x32x16_bf16(PAF(2),VFR(6),o[1],0,0,0), C1,4); \
    GAPB(o[0]=__builtin_amdgcn_mfma_f32_32x32x16_bf16(PAF(3),VFR(3),o[0],0,0,0), C1,8); \
    GAPB(o[1]=__builtin_amdgcn_mfma_f32_32x32x16_bf16(PAF(3),VFR(7),o[1],0,0,0), C1,12); \
    }while(0)
  int t=1;
  #undef CMASK
  #define CMASK(P0,P1,t) do{}while(0)
  for(;t+5<NT;t+=2){
    STEP(pB0,pB1,pA0,pA1,t,true,true,true);     WAIT_BAR(2); RESC(); ROT();
    STEP(pA0,pA1,pB0,pB1,t+1,true,true,true);   WAIT_BAR(2); RESC(); ROT();
  }
  #undef CMASK
  #define CMASK(P0,P1,t) do{}while(0)
  #define ENDW(tt) do{ if((tt)+3<NT){WAIT_BAR(2);} else if((tt)+2<NT){WAIT_BAR(1);} else {WAIT_BAR(0);} }while(0)
  for(;t+1<NT;t+=2){
    STEP(pB0,pB1,pA0,pA1,t,(t+3<NT),(t+1<NT),(t+1<NT));       ENDW(t);   RESC(); ROT();
    STEP(pA0,pA1,pB0,pB1,t+1,(t+4<NT),(t+2<NT),(t+2<NT));     ENDW(t+1); RESC(); ROT();
  }
  STEP(pB0,pB1,pA0,pA1,NT-1,false,false,false); RESC();
  { float sacc=pB0[0]+pB0[1]; _Pragma("unroll") for(int r=2;r<16;++r)sacc+=pB0[r]; _Pragma("unroll") for(int r=0;r<16;++r)sacc+=pB1[r]; l_reg+=sacc;
    pw0=(u32x4){PKW(pB0,0),PKW(pB0,2),PKW(pB0,4),PKW(pB0,6)};pw1=(u32x4){PKW(pB0,8),PKW(pB0,10),PKW(pB0,12),PKW(pB0,14)};pw2=(u32x4){PKW(pB1,0),PKW(pB1,2),PKW(pB1,4),PKW(pB1,6)};pw3=(u32x4){PKW(pB1,8),PKW(pB1,10),PKW(pB1,12),PKW(pB1,14)};
    SBAR(); pv(o,vb0+sl_cur,PAF(0),PAF(1),PAF(2),PAF(3)); }
  #undef PKW
  #undef PAF
  #undef VFR
  #undef PIN
  #undef MX3
  #undef GAPA
  #undef GAPB
  #undef EX
  #undef VRD
  #undef KRD
  #undef STEP
  #undef ENDW
  {auto rr=__builtin_amdgcn_permlane32_swap(__float_as_uint(l_reg),__float_as_uint(l_reg),false,false);l_reg=__uint_as_float(rr[0])+__uint_as_float(rr[1]);}
  if(hi==0)wsf[32+r32]=l_reg;asm volatile("s_waitcnt lgkmcnt(0)":::"memory");
  float rli[16];
  #pragma unroll
  for(int r=0;r<16;++r)rli[r]=__builtin_amdgcn_rcpf(wsf[32+crow(r,hi)]);
  bf16*Ow=O+(rowbase+q0+wid*QBLK)*OPT+OCOL+h*D;
  { bf16*stg=(bf16*)(shm+LDS_OST)+wid*2048;
    #pragma unroll
    for(int r=0;r<16;++r){const int orow=crow(r,hi);
      #pragma unroll
      for(int d0=0;d0<2;++d0)stg[orow*64+d0*32+r32]=__float2bfloat16(o[d0][r]*rli[r]);}
    asm volatile("s_waitcnt lgkmcnt(0)":::"memory");
    #pragma unroll
    for(int i=0;i<4;++i){const int row=i*8+(lane>>3),ch=lane&7; const u32x4 v=*(const u32x4*)(stg+row*64+ch*8); ATTN_STORE16(Ow+(long)row*OPT+ch*8,v);} }
  asm volatile("s_waitcnt lgkmcnt(0)\n\ts_barrier":::"memory");
  #undef DMA_K
  #undef DMA_V
  #undef CMASK
  #undef START
  #undef RESC
  #undef ROT
}
constexpr int ATTN_LDS_BYTES=LDS_BYTES;
#undef SBAR
#undef WAIT_BAR
}
#define GAS __attribute__((address_space(1)))
#define LAS __attribute__((address_space(3)))
typedef unsigned short bf16;
typedef unsigned v4u __attribute__((ext_vector_type(4)));
typedef float f32x4 __attribute__((ext_vector_type(4)));
typedef float f32x16 __attribute__((ext_vector_type(16)));
typedef short bf16x8 __attribute__((ext_vector_type(8)));
typedef unsigned u32x2 __attribute__((ext_vector_type(2)));
#define LDS_WAIT() asm volatile("s_waitcnt lgkmcnt(0)" ::: "memory")
__device__ __forceinline__ unsigned f2bf(float f) { unsigned u = __builtin_bit_cast(unsigned, f); return (u + 0x7fffu + ((u >> 16) & 1u)) >> 16; }
__device__ __forceinline__ unsigned pk2(float lo, float hi) { return f2bf(lo) | (f2bf(hi) << 16); }
__device__ __forceinline__ float wave_sum(float v) {
#pragma unroll
    for (int o = 1; o < 64; o <<= 1) v += __shfl_xor(v, o);
    return v;
}
constexpr int NWAVES = 8;
constexpr int LDS_BYTES = 147456;
constexpr size_t MiB = 1u << 20;
constexpr size_t WS_TAB = 1 * MiB;
constexpr size_t TAB_COSA = WS_TAB, TAB_SINA = WS_TAB + 8192, TAB_COSB = WS_TAB + 16384, TAB_SINB = WS_TAB + 16384 + 262144, TAB_QKN = WS_TAB + 16384 + 2 * 262144;
constexpr size_t WS_PART = 2 * MiB;
constexpr size_t WS_W13_1 = 8 * MiB, WS_W13_2 = 19 * MiB, WS_W2_1 = 30 * MiB, WS_W2_2 = 36 * MiB, WS_WIN = 42 * MiB, WS_WBA = 52 * MiB, WS_WBB = 53 * MiB, WS_WO = 54 * MiB;
constexpr size_t WS_XB = 60 * MiB;
constexpr size_t WS_R = 220 * MiB;
constexpr size_t R_QA = WS_R, R_KA = WS_R + 80 * MiB, R_VA = WS_R + 100 * MiB, R_QB = WS_R + 120 * MiB, R_KB = WS_R + 240 * MiB, R_VB = WS_R + 360 * MiB, R_GA = WS_R + 480 * MiB, R_GB = WS_R + 640 * MiB;
constexpr size_t R_TMP = WS_R + 120 * MiB, R_MG = WS_R + 280 * MiB;
constexpr size_t WS_END = 1020 * MiB;

__device__ __forceinline__ int rowmap(int mode, int n) {
    if (mode == 0) return n;
    if (mode == 1) { const int b = n >= DFF ? 1 : 0, j = n - b * DFF; return (j >> 7) * 256 + b * 128 + (j & 127); }
    const int pn = n >> 8, hl = (n >> 6) & 3; int dd = n & 63;
    if (pn >= 3 && pn < 9) { if (dd >= 8 && dd < 16) dd += 8; else if (dd >= 16 && dd < 24) dd -= 8; }
    const bool rope = (pn < 2) || (pn == 2 && hl < 2) || (pn >= 3 && pn < 9);
    const int dl = dd & 31;
    const int pos32 = rope ? dl : (16 * ((dl >> 2) & 1) + 4 * (dl >> 3) + (dl & 3));
    return pn * 256 + (dd >> 5) * 128 + hl * 32 + pos32;
}
__device__ __forceinline__ void p0_transpose_item(const float* W, const float* gain, int K, int N, bf16* WT, int mode, LAS float* scr, int item, int lane, int kpitch = 0, int koff = 0) {
    if (kpitch == 0) kpitch = K;
    const int nblk = N / 32, kb = item / nblk, nb = item % nblk, k0 = 64 * kb, n0 = 32 * nb;
#pragma unroll 8
    for (int i = 0; i < 32; ++i) { const int kk = 2 * i + (lane >> 5); const float gsc = gain ? gain[k0 + kk] : 1.0f; scr[kk * 33 + (lane & 31)] = W[(size_t)(k0 + kk) * N + n0 + (lane & 31)] * gsc; }
    LDS_WAIT(); asm volatile("" ::: "memory");
    const int c = lane & 7;
#pragma unroll
    for (int j = 0; j < 4; ++j) { const int n = (lane >> 3) + 8 * j; const LAS float* s = scr + (8 * c) * 33 + n;
        v4u o; o.x = pk2(s[0 * 33], s[1 * 33]); o.y = pk2(s[2 * 33], s[3 * 33]); o.z = pk2(s[4 * 33], s[5 * 33]); o.w = pk2(s[6 * 33], s[7 * 33]);
        *(GAS v4u*)(WT + (size_t)rowmap(mode, n0 + n) * kpitch + koff + k0 + 8 * c) = o; }
    LDS_WAIT(); asm volatile("" ::: "memory");
}

namespace dil {
constexpr int OPB = 144;
constexpr int L_O = 0, L_M = 512 * OPB, L_L = L_M + 2048, L_V = L_L + 2048;
static_assert(L_V + 8 * 4096 <= 147456, "dil LDS map");
typedef short v4i16_t __attribute__((ext_vector_type(4)));
__device__ __forceinline__ int crow(int r, int hi) { return (r & 3) + 8 * (r >> 2) + 4 * hi; }
typedef float f32x2_cv __attribute__((ext_vector_type(2))); typedef __bf16 bf16x2_cv __attribute__((ext_vector_type(2)));
__device__ __forceinline__ unsigned cvtpk(float lo, float hi) { const f32x2_cv v = {lo, hi}; return __builtin_bit_cast(unsigned, __builtin_convertvector(v, bf16x2_cv)); }
__device__ __forceinline__ v4i16_t vtr(const LAS unsigned char* p) { return __builtin_amdgcn_ds_read_tr16_b64_v4i16((LAS v4i16_t*)p); }
__device__ __forceinline__ float bflo(unsigned w) { return __uint_as_float(w << 16); }
__device__ __forceinline__ float bfhi(unsigned w) { return __uint_as_float(w & 0xffff0000u); }
__device__ __forceinline__ void unit(int u, const bf16* QB, const bf16* KB, const bf16* VB, bf16* OB, LAS unsigned char* lds) {
    const int tid = opaque_tid(), lane = tid & 63, wid = __builtin_amdgcn_readfirstlane(tid >> 6);
    const int blk = u >> 2, hs = u & 3, row0 = blk * 512;
    int S, seq0;
    if (row0 < T_PROMPT) { S = 4096; seq0 = row0 & ~4095; } else { S = 8192; seq0 = row0 & ~8191; }
    const int tb = row0 - seq0;
    LAS float* Ml = (LAS float*)(lds + L_M); LAS float* Ll = (LAS float*)(lds + L_L);
    LAS unsigned char* vst = lds + L_V + wid * 4096;
    const LAS unsigned char* vtrb = vst + ((lane >> 4) & 1) * 32 + (lane & 3) * 8 + (4 * (lane >> 5) + ((lane & 15) >> 2)) * 64;
    const int c32 = lane & 31, hi = lane >> 5;
#pragma unroll 1
    for (int g = 0; g < 3; ++g) {
        const int sh = 2 * g, nsub = 16 >> sh, Ld = S >> sh, h = g * 4 + hs;
#pragma unroll 1
        for (int jj = 0; jj < 2; ++jj) {
            const int j = 2 * wid + jj, r = j >> (4 - sh), sb = j & (nsub - 1);
            const int iq0 = (tb >> sh) + 32 * sb;
            const int tokl = r + ((32 * sb + c32) << sh);
            const size_t hb = ((size_t)h * T_ROWS + seq0 + (size_t)r * Ld) * 64;
            const bf16* qp = QB + hb + (size_t)(iq0 + c32) * 64 + hi * 8;
            bf16x8 qf[4], kf[5][4];
#pragma unroll
            for (int d0 = 0; d0 < 4; ++d0) qf[d0] = *(const bf16x8*)(qp + d0 * 16);
#pragma unroll
            for (int kb = 0; kb < 5; ++kb) {
                int ik = iq0 - 64 + 32 * kb + c32; ik = ik < 0 ? 0 : (ik > Ld - 1 ? Ld - 1 : ik);
                const bf16* kp = KB + hb + (size_t)ik * 64 + hi * 8;
#pragma unroll
                for (int d0 = 0; d0 < 4; ++d0) kf[kb][d0] = *(const bf16x8*)(kp + d0 * 16);
            }
            v4u vr[3][4];
#define DIL_VLOAD(kb_) do { _Pragma("unroll") for (int kg = 0; kg < 2; ++kg) { int kk = iq0 - 64 + 32 * (kb_) + 16 * kg + (lane >> 2); kk = kk < 0 ? 0 : (kk > Ld - 1 ? Ld - 1 : kk); \
                const bf16* vp = VB + hb + (size_t)kk * 64 + (lane & 3) * 8; \
                vr[(kb_) % 3][kg] = *(const v4u*)vp; vr[(kb_) % 3][2 + kg] = *(const v4u*)(vp + 32); } } while (0)
            f32x16 s[5];
            const bool interior = (iq0 >= 64) && (iq0 + 96 <= Ld);
#pragma unroll
            for (int kb = 0; kb < 5; ++kb) {
                f32x16 acc = {};
#pragma unroll
                for (int d0 = 0; d0 < 4; ++d0) acc = __builtin_amdgcn_mfma_f32_32x32x16_bf16(kf[kb][d0], qf[d0], acc, 0, 0, 0);
                if (interior) {
                    if (kb == 0) {
#pragma unroll
                        for (int rr = 0; rr < 16; ++rr) s[kb][rr] = (crow(rr, hi) >= c32) ? acc[rr] : -1e30f;
                    } else if (kb == 4) {
#pragma unroll
                        for (int rr = 0; rr < 16; ++rr) s[kb][rr] = (crow(rr, hi) <= c32) ? acc[rr] : -1e30f;
                    } else s[kb] = acc;
                } else {
#pragma unroll
                for (int rr = 0; rr < 16; ++rr) { const int kk = iq0 - 64 + 32 * kb + crow(rr, hi); const int dq = 32 * kb - 64 + crow(rr, hi) - c32;
                    const bool valid = (dq >= -64) && (dq <= 64) && (kk >= 0) && (kk < Ld); s[kb][rr] = valid ? acc[rr] : -1e30f; }
                }
            }
            DIL_VLOAD(0); DIL_VLOAD(1); DIL_VLOAD(2);
            float mx = -1e30f;
#pragma unroll
            for (int kb = 0; kb < 5; ++kb)
#pragma unroll
                for (int rr = 0; rr < 16; ++rr) mx = fmaxf(mx, s[kb][rr]);
            mx = xmax32(mx);
            float l = 0.f;
#pragma unroll
            for (int kb = 0; kb < 5; ++kb)
#pragma unroll
                for (int rr = 0; rr < 16; ++rr) { const float p = __builtin_amdgcn_exp2f(s[kb][rr] - mx); s[kb][rr] = p; l += p; }
            l = xsum32(l);
            f32x16 o[2]; o[0] = f32x16{}; o[1] = f32x16{};
#pragma unroll
            for (int kb = 0; kb < 5; ++kb) {
#pragma unroll
                for (int bl = 0; bl < 4; ++bl) *(LAS v4u*)(vst + bl * 1024 + lane * 16) = vr[kb % 3][bl];
                if (kb + 3 < 5) { DIL_VLOAD(kb + 3); }
#pragma unroll
                for (int ks = 0; ks < 2; ++ks) {
                    v4u pw; pw.x = cvtpk(s[kb][8 * ks + 0], s[kb][8 * ks + 1]); pw.y = cvtpk(s[kb][8 * ks + 2], s[kb][8 * ks + 3]); pw.z = cvtpk(s[kb][8 * ks + 4], s[kb][8 * ks + 5]); pw.w = cvtpk(s[kb][8 * ks + 6], s[kb][8 * ks + 7]);
                    const bf16x8 pf = __builtin_bit_cast(bf16x8, pw);
#pragma unroll
                    for (int db = 0; db < 2; ++db) {
                        const v4i16_t lo = vtr(vtrb + (db * 2 + ks) * 1024), hh = vtr(vtrb + (db * 2 + ks) * 1024 + 512);
                        const bf16x8 vf = (bf16x8){lo[0], lo[1], lo[2], lo[3], hh[0], hh[1], hh[2], hh[3]};
                        o[db] = __builtin_amdgcn_mfma_f32_32x32x16_bf16(vf, pf, o[db], 0, 0, 0);
                    }
                }
            }
#undef DIL_VLOAD
            LAS unsigned char* ob = lds + L_O + tokl * OPB + 8 * hi;
            if (g > 0) {
                const float mp = Ml[tokl], lp = Ll[tokl];
                const float mn = fmaxf(mp, mx), a = __builtin_amdgcn_exp2f(mp - mn), b = __builtin_amdgcn_exp2f(mx - mn);
#pragma unroll
                for (int blk2 = 0; blk2 < 2; ++blk2)
#pragma unroll
                    for (int k = 0; k < 4; ++k) { const u32x2 pv = *(const LAS u32x2*)(ob + 64 * blk2 + 16 * k);
                        o[blk2][4 * k + 0] = a * bflo(pv.x) + b * o[blk2][4 * k + 0]; o[blk2][4 * k + 1] = a * bfhi(pv.x) + b * o[blk2][4 * k + 1];
                        o[blk2][4 * k + 2] = a * bflo(pv.y) + b * o[blk2][4 * k + 2]; o[blk2][4 * k + 3] = a * bfhi(pv.y) + b * o[blk2][4 * k + 3]; }
                l = a * lp + b * l; mx = mn;
            }
            if (g < 2) {
#pragma unroll
                for (int blk2 = 0; blk2 < 2; ++blk2)
#pragma unroll
                    for (int k = 0; k < 4; ++k) { u32x2 w; w.x = cvtpk(o[blk2][4 * k], o[blk2][4 * k + 1]); w.y = cvtpk(o[blk2][4 * k + 2], o[blk2][4 * k + 3]); *(LAS u32x2*)(ob + 64 * blk2 + 16 * k) = w; }
                if (hi == 0) { Ml[tokl] = mx; Ll[tokl] = l; }
            } else {
                const float il = 1.0f / l;
                bf16* dp = OB + (size_t)(row0 + tokl) * 768 + hs * 64 + 4 * hi;
#pragma unroll
                for (int blk2 = 0; blk2 < 2; ++blk2)
#pragma unroll
                    for (int k = 0; k < 4; ++k) { u32x2 w; w.x = cvtpk(o[blk2][4 * k] * il, o[blk2][4 * k + 1] * il); w.y = cvtpk(o[blk2][4 * k + 2] * il, o[blk2][4 * k + 3] * il);
                        *(u32x2*)(dp + 32 * blk2 + 8 * k) = w; }
            }
        }
        __syncthreads();
    }
}
}

#define XB_TMO      128
#define XB_XCNT(j)  (256  + 64 * (j))
#define XB_XSUB(j)  (1280 + 64 * (j))
#define XB_XGEN(j)  (2304 + 64 * (j))
#define XB_TOP      3328
#define XB_TOPGEN   3392
#define XCD_BAR_WORDS 3456
#define XB_SPIN_CAP (1u << 18)

__device__ __forceinline__ unsigned xb_ld(unsigned* p)              { return __hip_atomic_load(p, __ATOMIC_RELAXED, __HIP_MEMORY_SCOPE_AGENT); }
__device__ __forceinline__ unsigned xb_add(unsigned* p, unsigned v) { return __hip_atomic_fetch_add(p, v, __ATOMIC_RELAXED, __HIP_MEMORY_SCOPE_AGENT); }
__device__ __forceinline__ unsigned xb_xcc_id() { return (unsigned)__builtin_amdgcn_s_getreg((3 << 11) | 20) & 0xFu; }
#define XB_SPIN(cond, bar) do { unsigned _sp = 0; while (cond) { __builtin_amdgcn_s_sleep(1); \
    if ((++_sp & 255u) == 0u) { if (xb_ld(&(bar)[XB_TMO])) break; if (_sp > XB_SPIN_CAP) { atomicAdd(&(bar)[XB_TMO], 1u); break; } } } } while (0)

struct XcdBarrier {
    unsigned* bar; unsigned x;
    volatile LAS unsigned* st;
};

__device__ __forceinline__ XcdBarrier xcd_barrier_post(unsigned* bar, volatile LAS unsigned* st) {
    XcdBarrier b; b.bar = bar; b.x = xb_xcc_id(); b.st = st;
    if (threadIdx.x == 0) (void)xb_add(&bar[XB_XCNT(b.x)], 1u);
    return b;
}
__device__ __forceinline__ void xcd_barrier_complete(unsigned* bar, unsigned x, unsigned& nloc, unsigned& nx) {
    const unsigned G = gridDim.x * gridDim.y * gridDim.z;
    unsigned sum, cnt, mine, sp = 0u;
    for (;;) {
        sum = 0u; cnt = 0u; mine = 0u;
#pragma unroll
        for (unsigned j = 0; j < 16; ++j) { const unsigned c = xb_ld(&bar[XB_XCNT(j)]); sum += c; cnt += (c > 0u) ? 1u : 0u; mine = (j == x) ? c : mine; }
        if (sum == G) break;
        __builtin_amdgcn_s_sleep(1);
        if ((++sp & 255u) == 0u) { if (xb_ld(&bar[XB_TMO])) break; if (sp > XB_SPIN_CAP) { atomicAdd(&bar[XB_TMO], 1u); break; } }
    }
    nloc = mine > 0u ? mine : 1u; nx = cnt > 0u ? cnt : 1u;
}

__device__ __forceinline__ void xcd_barrier(const XcdBarrier& b) {
    asm volatile("s_waitcnt vmcnt(0)" ::: "memory");
    __syncthreads();
    if (threadIdx.x == 0) {
        unsigned* bar = b.bar;
        __builtin_amdgcn_s_waitcnt(0);
        unsigned nloc = b.st[0], nx = b.st[1];
        if (nloc == 0u) { xcd_barrier_complete(bar, b.x, nloc, nx); b.st[0] = nloc; b.st[1] = nx; }
        const unsigned old = xb_add(&bar[XB_XSUB(b.x)], 1u);
        const unsigned gen = old / nloc;
        if (old + 1u == (gen + 1u) * nloc) {
            __builtin_amdgcn_fence(__ATOMIC_RELEASE, "agent");
            asm volatile("s_waitcnt vmcnt(0)" ::: "memory");
            const unsigned og = xb_add(&bar[XB_TOP], 1u);
            const unsigned tg = og / nx;
            if (og + 1u == (tg + 1u) * nx) xb_add(&bar[XB_TOPGEN], 1u);
            else XB_SPIN(xb_ld(&bar[XB_TOPGEN]) == tg, bar);
            __builtin_amdgcn_fence(__ATOMIC_ACQUIRE, "agent");
            xb_add(&bar[XB_XGEN(b.x)], 1u);
            asm volatile("s_waitcnt vmcnt(0)" ::: "memory");
        } else {
            XB_SPIN(xb_ld(&bar[XB_XGEN(b.x)]) == gen, bar);
            __builtin_amdgcn_fence(__ATOMIC_ACQUIRE, "agent");
            asm volatile("s_waitcnt vmcnt(0)" ::: "memory");
        }
    }
    __syncthreads();
}

constexpr size_t WS_BAR = 65536 * 4;
constexpr int MISC_OFF = 131072 + 320;
struct Args { const float* in[16]; float* out; unsigned char* ws; };

__global__ void __launch_bounds__(NWAVES * 64, 2) fwd_mega(Args args) {
    extern __shared__ __attribute__((aligned(16))) unsigned char lds[];
    cg::grid_group grid = cg::this_grid();
    LAS unsigned char* l3 = (LAS unsigned char*)lds;
    volatile LAS unsigned* bst = (volatile LAS unsigned*)(l3 + MISC_OFF);
    if (threadIdx.x < 2) bst[threadIdx.x] = 0u;
    const int G = gridDim.x, bx = blockIdx.x;
    const int vcu = (G % 8 == 0) ? (bx % 8) * (G / 8) + bx / 8 : bx;
    unsigned char* ws = args.ws;
    const float* xp = args.in[0]; const float* xs = args.in[1];
    float* out = args.out;
    float* part = (float*)(ws + WS_PART);
    bf16 *W13_1 = (bf16*)(ws + WS_W13_1), *W13_2 = (bf16*)(ws + WS_W13_2), *W2_1 = (bf16*)(ws + WS_W2_1), *W2_2 = (bf16*)(ws + WS_W2_2), *WIN = (bf16*)(ws + WS_WIN), *WBA = (bf16*)(ws + WS_WBA), *WBB = (bf16*)(ws + WS_WBB), *WO = (bf16*)(ws + WS_WO);
    bf16 *XB = (bf16*)(ws + WS_XB), *OCAT = (bf16*)out, *GH = (bf16*)(ws + WS_R);
    bf16 *QA = (bf16*)(ws + R_QA), *KA = (bf16*)(ws + R_KA), *VA = (bf16*)(ws + R_VA), *QBm = (bf16*)(ws + R_QB), *KBm = (bf16*)(ws + R_KB), *VBm = (bf16*)(ws + R_VB), *GA = (bf16*)(ws + R_GA), *GB = (bf16*)(ws + R_GB);
    bf16 *TMP = (bf16*)(ws + R_TMP), *MG = (bf16*)(ws + R_MG);
    float *cosA = (float*)(ws + TAB_COSA), *sinA = (float*)(ws + TAB_SINA), *cosB = (float*)(ws + TAB_COSB), *sinB = (float*)(ws + TAB_SINB), *qkn = (float*)(ws + TAB_QKN);
    const int NGW = G * NWAVES;

    {
        const int tid = opaque_tid(), lane = tid & 63, wave = __builtin_amdgcn_readfirstlane(tid >> 6), gw = vcu * NWAVES + wave;
        LAS float* scr = (LAS float*)(l3 + wave * 16384);
        constexpr int I13 = (1024 / 64) * (5632 / 32), I2 = (2816 / 64) * (1024 / 32), IIN = (1024 / 64) * (5120 / 32), IBA = (512 / 64) * (1024 / 32), IBB = (256 / 64) * (1024 / 32), IO = (1024 / 64) * (1024 / 32);
        constexpr int NITEMS = 2 * I13 + 2 * I2 + IIN + IBA + IBB + IO;
        for (int it = gw; it < NITEMS; it += NGW) {
            int r = it;
            if (r < I13) { p0_transpose_item(args.in[3], args.in[2], 1024, 5632, W13_1, 1, scr, r, lane); continue; } r -= I13;
            if (r < I13) { p0_transpose_item(args.in[13], args.in[12], 1024, 5632, W13_2, 1, scr, r, lane); continue; } r -= I13;
            if (r < I2) { p0_transpose_item(args.in[4], nullptr, 2816, 1024, W2_1, 0, scr, r, lane); continue; } r -= I2;
            if (r < I2) { p0_transpose_item(args.in[14], nullptr, 2816, 1024, W2_2, 0, scr, r, lane); continue; } r -= I2;
            if (r < IIN) { p0_transpose_item(args.in[6], args.in[5], 1024, 5120, WIN, 2, scr, r, lane); continue; } r -= IIN;
            if (r < IBA) { p0_transpose_item(args.in[9], nullptr, 512, 1024, WBA, 0, scr, r, lane, 768, 256); continue; } r -= IBA;
            if (r < IBB) { p0_transpose_item(args.in[10], nullptr, 256, 1024, WBA, 0, scr, r, lane, 768, 0); continue; } r -= IBB;
            p0_transpose_item(args.in[11], nullptr, 1024, 1024, WO, 0, scr, r, lane);
        }
        const int gt = vcu * 512 + tid, NGT = G * 512;
        if (gt < 128) qkn[gt] = gt < 64 ? args.in[7][gt] : args.in[8][gt - 64];
        if (bx == 0) for (int e = tid; e < XCD_BAR_WORDS; e += 512) ((unsigned*)(ws + WS_BAR))[e] = 0u;
        for (int e = gt; e < 128 * 16 + 8192 * 8; e += NGT) {
            if (e < 128 * 16) { const int pos = e >> 4, i = e & 15; const float inv = exp2f(-(float)(2 * i) / 32.0f * 13.287712379549449f); const float ang = (float)pos * inv; float sn, cs; sincosf(ang, &sn, &cs); cosA[e] = cs; sinA[e] = sn; }
            else { const int e2 = e - 128 * 16, pos = e2 >> 3, i = e2 & 7; const float inv = exp2f(-(float)(2 * i) / 16.0f * 18.931568569324174f); const float ang = (float)pos * inv; float sn, cs; sincosf(ang, &sn, &cs); cosB[e2] = cs; sinB[e2] = sn; }
        }
        for (int m = gw; m < T_ROWS; m += NGW) {
            const float* xr = (m < T_PROMPT) ? xp + (size_t)m * DMODEL : xs + (size_t)(m - T_PROMPT) * DMODEL;
            const GAS f32x4* x4 = (const GAS f32x4*)xr + lane;
            f32x4 v[4]; float s = 0.f;
#pragma unroll
            for (int j = 0; j < 4; ++j) { v[j] = __builtin_nontemporal_load(x4 + 64 * j); s += (v[j].x * v[j].x + v[j].y * v[j].y) + (v[j].z * v[j].z + v[j].w * v[j].w); }
            s = wave_sum(s);
            GAS unsigned long long* o8 = (GAS unsigned long long*)(XB + (size_t)m * DMODEL) + lane;
#pragma unroll
            for (int j = 0; j < 4; ++j) o8[64 * j] = (unsigned long long)pk2(v[j].x, v[j].y) | ((unsigned long long)pk2(v[j].z, v[j].w) << 32);
            if (lane < 16) part[(size_t)m * 16 + lane] = lane == 0 ? s : 0.f;
        }
    }
    grid.sync();
    const XcdBarrier xbar = xcd_barrier_post((unsigned*)(ws + WS_BAR), bst);
    { pg8::Gemm g{XB, W13_1, T_ROWS, 2 * DFF, DMODEL}; pg8::StaticOrder S; S.init(T_ROWS, 2 * DFF, G, bx); pg8::EpiSwiglu E{GH, part};
      pg8::gemm_phase<pg8::EpiSwiglu, pg8::StaticOrder, true, true>(l3, g, S, E); }
    xcd_barrier(xbar);
    { pg8::Gemm g{GH, W2_1, T_ROWS, DMODEL, DFF}; pg8::StaticOrder S; S.init(T_ROWS, DMODEL, G, bx); pg8::EpiResid<false> E{xp, xs, nullptr, nullptr, XB, part, 0.5f, 2.0f};
      pg8::gemm_phase<pg8::EpiResid<false>, pg8::StaticOrder, true, true, true>(l3, g, S, E); }
    xcd_barrier(xbar);
#ifndef NO_P3
    { pg8::Gemm g{XB, WIN, T_ROWS, INW, DMODEL}; pg8::StaticOrder S; S.init(T_ROWS, INW, G, bx);
      pg8::EpiProj E{QA, KA, VA, QBm, KBm, VBm, GA, GB, cosA, sinA, cosB, sinB, qkn, part};
      pg8::gemm_phase<pg8::EpiProj, pg8::StaticOrder, true, true>(l3, g, S, E); }
    xcd_barrier(xbar);
#endif
    {
#ifndef NO_ATTA
        for (int i = vcu; i < 2560; i += G) {
            long rowbase; int S, h, q0;
            if (i < 2048) { const int seq = i >> 7, rem = i & 127; h = (rem >> 4); q0 = (rem & 15) * 256; rowbase = (long)seq * 4096; S = 4096; }
            else { const int i2 = i - 2048, seq = i2 >> 8, rem = i2 & 255; h = (rem >> 5); q0 = (rem & 31) * 256; rowbase = (long)T_PROMPT + (long)seq * 8192; S = 8192; }
            attn_body::attn_unit<8>(rowbase, S, h, q0, (const attn_body::bf16*)QA, (const attn_body::bf16*)KA, (const attn_body::bf16*)VA, (attn_body::bf16*)OCAT, (char*)lds);
        }
#endif
        __syncthreads();
#ifndef NO_ATTB
        for (int u = vcu; u < 640; u += G) dil::unit(u, QBm, KBm, VBm, OCAT, l3);
#endif
    }
    xcd_barrier(xbar);
    { pg8::Gemm g{OCAT, WBA, T_ROWS, DMODEL, 768}; pg8::StaticOrder S; S.init(T_ROWS, DMODEL, G, bx); pg8::EpiGate2 E{GA, GB, MG};
      pg8::gemm_phase<pg8::EpiGate2, pg8::StaticOrder, true, true>(l3, g, S, E); }
    xcd_barrier(xbar);
    { pg8::Gemm g{MG, WO, T_ROWS, DMODEL, DMODEL}; pg8::StaticOrder S; S.init(T_ROWS, DMODEL, G, bx); pg8::EpiResid<true> E{nullptr, nullptr, XB, nullptr, XB, part, 1.0f, 1.0f};
      pg8::gemm_phase<pg8::EpiResid<true>, pg8::StaticOrder, true, true>(l3, g, S, E); }
    xcd_barrier(xbar);
    { pg8::Gemm g{XB, W13_2, T_ROWS, 2 * DFF, DMODEL}; pg8::StaticOrder S; S.init(T_ROWS, 2 * DFF, G, bx); pg8::EpiSwiglu E{GH, part};
      pg8::gemm_phase<pg8::EpiSwiglu, pg8::StaticOrder, true, true>(l3, g, S, E); }
    xcd_barrier(xbar);
    { pg8::Gemm g{GH, W2_2, T_ROWS, DMODEL, DFF}; pg8::StaticOrder S; S.init(T_ROWS, DMODEL, G, bx); pg8::EpiResid<true> E{nullptr, nullptr, XB, out, nullptr, part, 0.5f, 2.0f};
      pg8::gemm_phase<pg8::EpiResid<true>, pg8::StaticOrder, true, true, true>(l3, g, S, E); }
    xcd_barrier(xbar);
    {
        const int tid = opaque_tid(), lane = tid & 63, wave = __builtin_amdgcn_readfirstlane(tid >> 6), gw = vcu * NWAVES + wave;
        const float* gf = args.in[15];
        f32x4 gv[4];
#pragma unroll
        for (int j = 0; j < 4; ++j) gv[j] = *((const f32x4*)gf + lane + 64 * j);
        for (int m = gw; m < T_ROWS; m += NGW) {
            const f32x4 p0 = *(const f32x4*)(part + (size_t)m * 16), p1 = *(const f32x4*)(part + (size_t)m * 16 + 4), p2 = *(const f32x4*)(part + (size_t)m * 16 + 8), p3 = *(const f32x4*)(part + (size_t)m * 16 + 12);
            const f32x4 pq = (p0 + p1) + (p2 + p3);
            const float s = (pq[0] + pq[1]) + (pq[2] + pq[3]);
            const float rs = rsqrtf(s * (1.0f / 1024.0f) + RMS_EPS);
            GAS f32x4* o4 = (GAS f32x4*)(out + (size_t)m * DMODEL) + lane;
#pragma unroll
            for (int j = 0; j < 4; ++j) { f32x4 v = o4[64 * j]; v = v * rs * gv[j]; __builtin_nontemporal_store(v, o4 + 64 * j); }
        }
    }
}

extern "C" void kernel_launch(void* const* d_in, const int* in_sizes, int n_in, void* d_out, int out_size, void* d_ws, size_t ws_size, hipStream_t stream) {
    static int grid = 0;
    if (grid == 0) {
        if (n_in != 16 || out_size != T_ROWS * DMODEL || ws_size < WS_END) { fprintf(stderr, "kernel_launch: unexpected problem (n_in %d out %d ws %zu); nothing launched\n", n_in, out_size, ws_size); grid = -1; return; }
        int dev = 0, cus = 0, per_cu = 0;
        if (hipGetDevice(&dev) != hipSuccess || hipDeviceGetAttribute(&cus, hipDeviceAttributeMultiprocessorCount, dev) != hipSuccess) { grid = -1; return; }
        if (hipFuncSetAttribute((const void*)fwd_mega, hipFuncAttributeMaxDynamicSharedMemorySize, LDS_BYTES) != hipSuccess) { fprintf(stderr, "kernel_launch: hipFuncSetAttribute failed\n"); grid = -1; return; }
        if (hipOccupancyMaxActiveBlocksPerMultiprocessor(&per_cu, (const void*)fwd_mega, NWAVES * 64, LDS_BYTES) != hipSuccess || per_cu < 1) { fprintf(stderr, "kernel_launch: occupancy query says %d\n", per_cu); per_cu = 1; }
        (void)hipGetLastError();
        grid = cus;
    }
    if (grid < 0) return;
    Args a{};
    for (int i = 0; i < 16; ++i) a.in[i] = (const float*)d_in[i];
    a.out = (float*)d_out; a.ws = (unsigned char*)d_ws;
    void* kargs[] = {&a};
    hipError_t e = hipLaunchCooperativeKernel((const void*)fwd_mega, dim3(grid), dim3(NWAVES * 64), kargs, LDS_BYTES, stream);
    if (e != hipSuccess) fprintf(stderr, "cooperative launch failed: %s (grid %d)\n", hipGetErrorString(e), grid);
}
```
